# Optimizing an MI355X kernel written in HIP

```python
import jax, jax.numpy as jnp
from jax import lax
import numpy as np

D_MODEL = 1024
BATCH = 8
SEQ = 4096
DEPTH = 4

HEAD_DIM = 64
N_HEADS_A = 8
N_HEADS_B = 8
N_HEADS_C = 8
WIDTH_A = N_HEADS_A * HEAD_DIM
WIDTH_B = N_HEADS_B * HEAD_DIM
WIDTH_C = N_HEADS_C * HEAD_DIM
WIDTH_D = D_MODEL // 2
POOL_WINDOWS = (2, 4, 8, 16)
N_POOL_GROUPS = len(POOL_WINDOWS)
POOL_GROUP_DIM = WIDTH_D // N_POOL_GROUPS
CHUNK = 128
Q_BLOCK = 128
PLE_DIM = 256
N_EXPERT_GROUPS = 4
EXPERTS_PER_GROUP = 4
N_EXPERTS = N_EXPERT_GROUPS * EXPERTS_PER_GROUP
TOP_K_INNER = 2
D_EXPERT = 256
RMS_EPS = 1e-6
N_EVEN = (DEPTH + 1) // 2
N_ODD = DEPTH // 2
EVEN_IN = 2 * WIDTH_A + 3 * WIDTH_B
ODD_IN = 3 * WIDTH_C + N_HEADS_C + WIDTH_D

kernel_name = "hybrid_sgu_stickbreak_fox_pool_hmoe"


def _rms_unit(x):
    xf = x.astype(jnp.float32)
    return (xf * lax.rsqrt(jnp.mean(xf * xf, axis=-1, keepdims=True) + RMS_EPS)).astype(x.dtype)


def rmsnorm(x, g):
    xf = x.astype(jnp.float32)
    y = xf * lax.rsqrt(jnp.mean(xf * xf, axis=-1, keepdims=True) + RMS_EPS)
    return (y * g.astype(jnp.float32)).astype(x.dtype)


def spatial_gating(u, v, w_s, b_s, g_v):
    bsz, seq, nh, hd = u.shape
    nc = seq // CHUNK
    u = jax.nn.gelu(u)
    v = rmsnorm(jax.nn.gelu(v), g_v)
    mask = jnp.tril(jnp.ones((CHUNK, CHUNK), dtype=bool))
    w = jnp.where(mask, w_s, 0.0)
    vc = v.reshape(bsz, nc, CHUNK, nh, hd)
    mixed = jnp.einsum('hts,bcshd->bcthd', w, vc) + b_s.T[None, None, :, :, None]
    return u * mixed.reshape(bsz, seq, nh, hd)


def stick_breaking_attention(q, k, v):
    bsz, seq, nh, hd = q.shape
    nb = seq // Q_BLOCK
    kf = k.astype(jnp.float32)
    vf = v.astype(jnp.float32)
    qb = q.astype(jnp.float32).reshape(bsz, nb, Q_BLOCK, nh, hd).swapaxes(0, 1)
    key_pos = jnp.arange(seq)
    scale = hd ** -0.5

    def block(args):
        q_blk, blk = args
        q_pos = blk * Q_BLOCK + jnp.arange(Q_BLOCK)
        strict = key_pos[None, :] < q_pos[:, None]
        z = jnp.einsum('bqhd,bkhd->bhqk', q_blk, kf) * scale
        log_1m_beta = jnp.where(strict, jax.nn.log_sigmoid(-z), 0.0)
        between = lax.cumsum(log_1m_beta, axis=3, reverse=True) - log_1m_beta
        weights = jnp.where(strict, jnp.exp(jax.nn.log_sigmoid(z) + between), 0.0)
        return jnp.einsum('bhqk,bkhd->bqhd', weights, vf)

    out = lax.map(block, (qb, jnp.arange(nb)))
    return out.swapaxes(0, 1).reshape(bsz, seq, nh, hd).astype(q.dtype)


def forgetting_attention(q, k, v, log_f):
    bsz, seq, nh, hd = q.shape
    nb = seq // Q_BLOCK
    cum_f = jnp.cumsum(log_f.astype(jnp.float32), axis=1)
    f_key = cum_f.transpose(0, 2, 1)
    f_qb = cum_f.reshape(bsz, nb, Q_BLOCK, nh).swapaxes(0, 1)
    kf = k.astype(jnp.float32)
    vf = v.astype(jnp.float32)
    qb = q.astype(jnp.float32).reshape(bsz, nb, Q_BLOCK, nh, hd).swapaxes(0, 1)
    key_pos = jnp.arange(seq)
    scale = hd ** -0.5

    def block(args):
        q_blk, fq_blk, blk = args
        q_pos = blk * Q_BLOCK + jnp.arange(Q_BLOCK)
        causal = key_pos[None, :] <= q_pos[:, None]
        z = (jnp.einsum('bqhd,bkhd->bhqk', q_blk, kf) * scale
             + fq_blk.transpose(0, 2, 1)[..., None] - f_key[:, :, None, :])
        probs = jax.nn.softmax(jnp.where(causal, z, -jnp.inf), axis=-1)
        return jnp.einsum('bhqk,bkhd->bqhd', probs, vf)

    out = lax.map(block, (qb, f_qb, jnp.arange(nb)))
    return out.swapaxes(0, 1).reshape(bsz, seq, nh, hd).astype(q.dtype)


def multiscale_pool(xd, w_pool, pool_scale):
    bsz, seq, _ = xd.shape
    xg = xd.astype(jnp.float32).reshape(bsz, seq, N_POOL_GROUPS, POOL_GROUP_DIM)
    cs = jnp.concatenate([jnp.zeros((bsz, 1, N_POOL_GROUPS, POOL_GROUP_DIM), jnp.float32),
                          jnp.cumsum(xg, axis=1)], axis=1)
    pos = jnp.arange(seq)
    outs = []
    for g, win in enumerate(POOL_WINDOWS):
        csg = cs[:, :, g]
        start = jnp.maximum(pos + 1 - win, 0)
        count = (pos + 1 - start).astype(jnp.float32)
        mean = (csg[:, 1:] - csg[:, start]) / count[None, :, None]
        outs.append(mean - xg[:, :, g])
    pooled = jnp.stack(outs, axis=2)
    mixed = jnp.einsum('bsgc,gcd->bsgd', pooled, w_pool.astype(jnp.float32))
    return (mixed.reshape(bsz, seq, WIDTH_D) * pool_scale.astype(jnp.float32)).astype(xd.dtype)


def even_mixer(h, w_in, sgu_w, sgu_b, sgu_norm, w_out):
    bsz, seq, _ = h.shape
    proj = h @ w_in
    u, va, q, k, vb = jnp.split(
        proj, [WIDTH_A, 2 * WIDTH_A, 2 * WIDTH_A + WIDTH_B, 2 * WIDTH_A + 2 * WIDTH_B], axis=-1)
    heads = lambda t, n: t.reshape(bsz, seq, n, HEAD_DIM)
    ya = spatial_gating(heads(u, N_HEADS_A), heads(va, N_HEADS_A), sgu_w, sgu_b, sgu_norm)
    yb = stick_breaking_attention(heads(q, N_HEADS_B), heads(k, N_HEADS_B), heads(vb, N_HEADS_B))
    y = jnp.concatenate([ya.reshape(bsz, seq, WIDTH_A), yb.reshape(bsz, seq, WIDTH_B)], axis=-1)
    return y @ w_out


def odd_mixer(h, w_in, forget_bias, q_norm, k_norm, pool_w, pool_scale, w_out):
    bsz, seq, _ = h.shape
    proj = h @ w_in
    q, k, v, f_logit, xd = jnp.split(
        proj, [WIDTH_C, 2 * WIDTH_C, 3 * WIDTH_C, 3 * WIDTH_C + N_HEADS_C], axis=-1)
    heads = lambda t: t.reshape(bsz, seq, N_HEADS_C, HEAD_DIM)
    q = rmsnorm(heads(q), q_norm)
    k = rmsnorm(heads(k), k_norm)
    log_f = jax.nn.log_sigmoid(f_logit.astype(jnp.float32) + forget_bias.astype(jnp.float32))
    yc = forgetting_attention(q, k, heads(v), log_f)
    yd = multiscale_pool(xd, pool_w, pool_scale)
    y = jnp.concatenate([yc.reshape(bsz, seq, WIDTH_C), yd], axis=-1)
    return y @ w_out


def hierarchical_moe(h, rg_w, rg_b, re_w, re_b, w_gate, w_up, w_down):
    def one_sequence(t):
        n_tok = t.shape[0]
        group_prob = jax.nn.softmax((t @ rg_w).astype(jnp.float32) + rg_b.astype(jnp.float32), axis=-1)
        g_p, g_idx = lax.top_k(group_prob, 1)
        e_logits = ((t @ re_w).astype(jnp.float32) + re_b.astype(jnp.float32)).reshape(
            n_tok, N_EXPERT_GROUPS, EXPERTS_PER_GROUP)
        in_group = jnp.take_along_axis(e_logits, g_idx[:, :, None], axis=1)[:, 0]
        e_top, e_idx = lax.top_k(in_group, TOP_K_INNER)
        e_w = jax.nn.softmax(e_top, axis=-1) * g_p
        flat_idx = g_idx * EXPERTS_PER_GROUP + e_idx
        gates = jnp.sum(jax.nn.one_hot(flat_idx, N_EXPERTS, dtype=jnp.float32) * e_w[..., None], axis=1)
        hg = jnp.einsum('sd,edf->sef', t, w_gate)
        hu = jnp.einsum('sd,edf->sef', t, w_up)
        act = jax.nn.silu(hg) * hu * gates[:, :, None].astype(t.dtype)
        return jnp.einsum('sef,efd->sd', act, w_down)

    return lax.map(one_sequence, h)


def per_layer_embedding(h, p_i, w_proj, g_norm, w_gate):
    e = rmsnorm(p_i @ w_proj, g_norm)
    gate = jax.nn.sigmoid(_rms_unit(h) @ w_gate)
    return h + gate * e


def setup_inputs(seed: int = 0) -> dict:
    key = jax.random.key(seed)
    ks = iter(jax.random.split(key, 32))
    nrm = lambda shape, scale: jax.random.normal(next(ks), shape, jnp.float32) * scale
    gain = lambda shape: 1.0 + 0.02 * jax.random.normal(next(ks), shape, jnp.float32)
    return {
        "x": nrm((BATCH, SEQ, D_MODEL), 1.0),
        "p": nrm((DEPTH, BATCH, SEQ, PLE_DIM), 1.0),
        "norm_mix": gain((DEPTH, D_MODEL)),
        "norm_ffn": gain((DEPTH, D_MODEL)),
        "even_w_in": nrm((N_EVEN, D_MODEL, EVEN_IN), D_MODEL ** -0.5),
        "sgu_w": nrm((N_EVEN, N_HEADS_A, CHUNK, CHUNK), CHUNK ** -0.5),
        "sgu_b": gain((N_EVEN, N_HEADS_A, CHUNK)),
        "sgu_norm": gain((N_EVEN, N_HEADS_A, HEAD_DIM)),
        "even_w_out": nrm((N_EVEN, WIDTH_A + WIDTH_B, D_MODEL), (WIDTH_A + WIDTH_B) ** -0.5),
        "odd_w_in": nrm((N_ODD, D_MODEL, ODD_IN), D_MODEL ** -0.5),
        "forget_bias": jax.random.uniform(next(ks), (N_ODD, N_HEADS_C), jnp.float32, 1.0, 4.0),
        "q_norm": gain((N_ODD, HEAD_DIM)),
        "k_norm": gain((N_ODD, HEAD_DIM)),
        "pool_w": nrm((N_ODD, N_POOL_GROUPS, POOL_GROUP_DIM, POOL_GROUP_DIM), POOL_GROUP_DIM ** -0.5),
        "pool_scale": 1.0 + 0.1 * jax.random.normal(next(ks), (N_ODD, WIDTH_D), jnp.float32),
        "odd_w_out": nrm((N_ODD, WIDTH_C + WIDTH_D, D_MODEL), (WIDTH_C + WIDTH_D) ** -0.5),
        "router_group_w": nrm((DEPTH, D_MODEL, N_EXPERT_GROUPS), D_MODEL ** -0.5),
        "router_group_b": nrm((DEPTH, N_EXPERT_GROUPS), 0.01),
        "router_expert_w": nrm((DEPTH, D_MODEL, N_EXPERTS), D_MODEL ** -0.5),
        "router_expert_b": nrm((DEPTH, N_EXPERTS), 0.01),
        "expert_w_gate": nrm((DEPTH, N_EXPERTS, D_MODEL, D_EXPERT), D_MODEL ** -0.5),
        "expert_w_up": nrm((DEPTH, N_EXPERTS, D_MODEL, D_EXPERT), D_MODEL ** -0.5),
        "expert_w_down": nrm((DEPTH, N_EXPERTS, D_EXPERT, D_MODEL), D_EXPERT ** -0.5),
        "ple_w_proj": nrm((DEPTH, PLE_DIM, D_MODEL), PLE_DIM ** -0.5),
        "ple_norm": gain((DEPTH, D_MODEL)),
        "ple_w_gate": nrm((DEPTH, D_MODEL, D_MODEL), D_MODEL ** -0.5),
    }


def reference(x, p, norm_mix, norm_ffn, even_w_in, sgu_w, sgu_b, sgu_norm, even_w_out,
              odd_w_in, forget_bias, q_norm, k_norm, pool_w, pool_scale, odd_w_out,
              router_group_w, router_group_b, router_expert_w, router_expert_b,
              expert_w_gate, expert_w_up, expert_w_down, ple_w_proj, ple_norm, ple_w_gate):
    h = x
    for i in range(DEPTH):
        j = i // 2
        hn = rmsnorm(h, norm_mix[i])
        if i % 2 == 0:
            h = h + even_mixer(hn, even_w_in[j], sgu_w[j], sgu_b[j], sgu_norm[j], even_w_out[j])
        else:
            h = h + odd_mixer(hn, odd_w_in[j], forget_bias[j], q_norm[j], k_norm[j],
                              pool_w[j], pool_scale[j], odd_w_out[j])
        h = h + hierarchical_moe(rmsnorm(h, norm_ffn[i]), router_group_w[i], router_group_b[i],
                                 router_expert_w[i], router_expert_b[i],
                                 expert_w_gate[i], expert_w_up[i], expert_w_down[i])
        h = per_layer_embedding(h, p[i], ple_w_proj[i], ple_norm[i], ple_w_gate[i])
    return h
```

```cpp
#include <hip/hip_runtime.h>
#include <cstdio>
#include <cstdint>

#ifndef MEGA
#define MEGA 1
#endif
#ifndef PROBE2
#define PROBE2 0
#endif
#ifndef PROBE_BAR
#define PROBE_BAR 0
#endif
#ifndef PROBE_MASK
#define PROBE_MASK 0
#endif

#define LAS __attribute__((address_space(3)))
typedef unsigned short bf16_t;
typedef short bf16x8 __attribute__((ext_vector_type(8)));
typedef short s16x4 __attribute__((ext_vector_type(4)));
typedef float f32x4 __attribute__((ext_vector_type(4)));
typedef float f32x2 __attribute__((ext_vector_type(2)));
typedef float f32x16 __attribute__((ext_vector_type(16)));
typedef unsigned u32x4 __attribute__((ext_vector_type(4)));
typedef unsigned u32x2 __attribute__((ext_vector_type(2)));

constexpr int T = 32768, D = 1024, SEQ = 4096, NBATCH = 8;
constexpr int EVEN_IN = 2560, ODD_IN = 2056, ODD_N = 2048;
constexpr int NEXP = 16, DEXP = 256, PLE = 256;
constexpr float EPS = 1e-6f;
constexpr float LOG2E = 1.4426950408889634f;
constexpr float QSCALE = 0.125f * LOG2E;
constexpr int NTHREADS = 512;
constexpr int ROWCAP = 65536 + 4096;

constexpr size_t MiB = 1u << 20;
constexpr size_t WS_CTL = 0, CTL_BYTES = 1 * MiB;
constexpr size_t WS_HB = 1 * MiB;
constexpr size_t WS_R1 = 65 * MiB;
constexpr size_t WS_R2 = 225 * MiB;
constexpr size_t WS_R3 = 289 * MiB;
constexpr size_t WS_SM = 353 * MiB;
constexpr size_t WS_W = 369 * MiB;
constexpr size_t SM_SSA = 0, SM_SSB = 2 * MiB, SM_SSE = 4 * MiB, SM_RSTD1 = 6 * MiB, SM_RSTD2 = 6 * MiB + 131072, SM_RSTDE = 15 * MiB,
                 SM_TOKREC = 6 * MiB + 262144, SM_LOGF = 7 * MiB, SM_COUNTS = 8 * MiB, SM_LISTS = 8 * MiB + 65536,
                 SM_ROWTOK = 11 * MiB, SM_ROWW = 11 * MiB + 524288, SM_ROWRS = 12 * MiB, SM_EBASE = 12 * MiB + 524288,
                 SM_WF = 13 * MiB, SM_WFB = 13 * MiB + 524288, SM_RWB = 14 * MiB;
constexpr size_t WE_IN = 0;
constexpr size_t WE_OUT = WE_IN + 2 * (size_t)EVEN_IN * D;
constexpr size_t WE_SGU = WE_OUT + 2 * (size_t)D * D;
constexpr size_t WO_IN = WE_SGU + 2 * (size_t)8 * 128 * 128;
constexpr size_t WO_OUT = WO_IN + 2 * (size_t)ODD_N * D;
constexpr size_t WO_POOL = WO_OUT + 2 * (size_t)D * D;
constexpr size_t WL_UP = WO_POOL + 2 * (size_t)4 * 128 * 128;
constexpr size_t WL_DN = WL_UP + 4 * (size_t)NEXP * 512 * D;
constexpr size_t WL_PP = WL_DN + 4 * (size_t)NEXP * D * DEXP;
constexpr size_t WL_PG = WL_PP + 4 * (size_t)D * PLE;
constexpr size_t W_END = WL_PG + 4 * (size_t)D * D;
constexpr size_t WS_END = WS_W + W_END * 2;
static_assert(WS_END <= 512 * MiB, "workspace map exceeds 512 MiB");

constexpr int RING_BYTES = 131072;
constexpr int MISC_OFF = RING_BYTES;
constexpr int RSTD_TAB = MISC_OFF + 256;
constexpr int LDS_BYTES = RING_BYTES + 8192;

struct Params { const float* in[26]; float* out; unsigned char* ws; };
typedef const __attribute__((address_space(4))) Params CParams;

__device__ __forceinline__ unsigned cvt_pk_bf16(float lo, float hi) { unsigned r; asm volatile("v_cvt_pk_bf16_f32 %0, %1, %2" : "=v"(r) : "v"(lo), "v"(hi)); return r; }
__device__ __forceinline__ float bf_lo(unsigned w) { return __uint_as_float(w << 16); }
__device__ __forceinline__ float bf_hi(unsigned w) { return __uint_as_float(w & 0xffff0000u); }
__device__ __forceinline__ float fast_exp2(float x) { return __builtin_amdgcn_exp2f(x); }
__device__ __forceinline__ float fast_rcp(float x) { return __builtin_amdgcn_rcpf(x); }
__device__ __forceinline__ float gelu_tanh(float x) { const float t = x * (1.0f + 0.044715f * x * x); return x * fast_rcp(1.0f + fast_exp2(-2.302208198f * t)); }
__device__ __forceinline__ float sigmoid_f(float x) { return fast_rcp(1.0f + fast_exp2(-LOG2E * x)); }
__device__ __forceinline__ float rstd_from16(const float* ss16) {
    const f32x4 a = *(const f32x4*)(ss16), b = *(const f32x4*)(ss16 + 4), c = *(const f32x4*)(ss16 + 8), d = *(const f32x4*)(ss16 + 12);
    const float s = ((a[0] + a[1]) + (a[2] + a[3])) + ((b[0] + b[1]) + (b[2] + b[3])) + ((c[0] + c[1]) + (c[2] + c[3])) + ((d[0] + d[1]) + (d[2] + d[3]));
    return 1.0f / sqrtf(s * (1.0f / 1024.0f) + EPS);
}
__device__ __forceinline__ float sum_x32(float x) { const auto rr = __builtin_amdgcn_permlane32_swap(__float_as_uint(x), __float_as_uint(x), false, false); return __uint_as_float(rr[0]) + __uint_as_float(rr[1]); }
__device__ __forceinline__ float max_x32(float x) { const auto rr = __builtin_amdgcn_permlane32_swap(__float_as_uint(x), __float_as_uint(x), false, false); return fmaxf(__uint_as_float(rr[0]), __uint_as_float(rr[1])); }
__device__ __forceinline__ float other_x32(float x, int hh) { const auto rr = __builtin_amdgcn_permlane32_swap(__float_as_uint(x), __float_as_uint(x), false, false); return __uint_as_float(hh ? rr[0] : rr[1]); }
__device__ __forceinline__ float sum_x16(float x) { const auto rr = __builtin_amdgcn_permlane16_swap(__float_as_uint(x), __float_as_uint(x), false, false); return __uint_as_float(rr[0]) + __uint_as_float(rr[1]); }
template <int CTRL> __device__ __forceinline__ float dpp_f(float x) { return __int_as_float(__builtin_amdgcn_update_dpp(0, __float_as_int(x), CTRL, 0xf, 0xf, true)); }
__device__ __forceinline__ float sum_row16(float x) { x += dpp_f<0xB1>(x); x += dpp_f<0x4E>(x); x += dpp_f<0x124>(x); x += dpp_f<0x128>(x); return x; }
__device__ __forceinline__ float wave_sum(float x) { return sum_x32(sum_x16(sum_row16(x))); }
typedef short v4i16_t __attribute__((ext_vector_type(4)));
__device__ __forceinline__ s16x4 tr_read(LAS unsigned char* p) { return __builtin_bit_cast(s16x4, __builtin_amdgcn_ds_read_tr16_b64_v4i16((LAS v4i16_t*)p)); }
#define MFMA32(a, b, c) __builtin_amdgcn_mfma_f32_32x32x16_bf16((a), (b), (c), 0, 0, 0)

#define XB_TMO      128
#define XB_XCNT(j)  (256  + 64 * (j))
#define XB_XSUB(j)  (1280 + 64 * (j))
#define XB_XGEN(j)  (2304 + 64 * (j))
#define XB_TOP      3328
#define XB_TOPGEN   3392
#define XCD_BAR_WORDS 3456
#define XB_SPIN_CAP (1u << 18)
__device__ __forceinline__ unsigned xb_ld(unsigned* p)              { return __hip_atomic_load(p, __ATOMIC_RELAXED, __HIP_MEMORY_SCOPE_AGENT); }
__device__ __forceinline__ unsigned xb_add(unsigned* p, unsigned v) { return __hip_atomic_fetch_add(p, v, __ATOMIC_RELAXED, __HIP_MEMORY_SCOPE_AGENT); }
__device__ __forceinline__ unsigned xb_xcc_id() { return (unsigned)__builtin_amdgcn_s_getreg((3 << 11) | 20) & 0xFu; }
#define XB_SPIN(cond, bar) do { unsigned _sp = 0; while (cond) { __builtin_amdgcn_s_sleep(1); \
    if ((++_sp & 255u) == 0u) { if (xb_ld(&(bar)[XB_TMO])) break; if (_sp > XB_SPIN_CAP) { atomicAdd(&(bar)[XB_TMO], 1u); break; } } } } while (0)
struct XcdBarrier { unsigned* bar; unsigned x; volatile LAS unsigned* st; };
__device__ __forceinline__ XcdBarrier xcd_barrier_post(unsigned* bar, volatile LAS unsigned* st) {
    XcdBarrier b; b.bar = bar; b.x = xb_xcc_id(); b.st = st;
    if (threadIdx.x == 0) (void)xb_add(&bar[XB_XCNT(b.x)], 1u);
    return b;
}
__device__ __forceinline__ void xcd_barrier_complete(unsigned* bar, unsigned x, unsigned& nloc, unsigned& nx) {
    const unsigned G = gridDim.x * gridDim.y * gridDim.z;
    unsigned sum, cnt, mine, sp = 0u;
    for (;;) {
        sum = 0u; cnt = 0u; mine = 0u;
#pragma unroll
        for (unsigned j = 0; j < 16; ++j) { const unsigned c = xb_ld(&bar[XB_XCNT(j)]); sum += c; cnt += (c > 0u) ? 1u : 0u; mine = (j == x) ? c : mine; }
        if (sum == G) break;
        __builtin_amdgcn_s_sleep(1);
        if ((++sp & 255u) == 0u) { if (xb_ld(&bar[XB_TMO])) break; if (sp > XB_SPIN_CAP) { atomicAdd(&bar[XB_TMO], 1u); break; } }
    }
    nloc = mine > 0u ? mine : 1u; nx = cnt > 0u ? cnt : 1u;
}
__device__ __forceinline__ void xcd_barrier(const XcdBarrier& b, const bool is_t0) {
    asm volatile("s_waitcnt vmcnt(0)" ::: "memory");
    __syncthreads();
    if (is_t0) {
        unsigned* bar = b.bar;
        __builtin_amdgcn_s_waitcnt(0);
        unsigned nloc = b.st[0], nx = b.st[1];
        if (nloc == 0u) { xcd_barrier_complete(bar, b.x, nloc, nx); b.st[0] = nloc; b.st[1] = nx; }
        const unsigned old = xb_add(&bar[XB_XSUB(b.x)], 1u);
        const unsigned gen = old / nloc;
        if (old + 1u == (gen + 1u) * nloc) {
            __builtin_amdgcn_fence(__ATOMIC_RELEASE, "agent");
            asm volatile("s_waitcnt vmcnt(0)" ::: "memory");
            const unsigned og = xb_add(&bar[XB_TOP], 1u);
            const unsigned tg = og / nx;
            if (og + 1u == (tg + 1u) * nx) xb_add(&bar[XB_TOPGEN], 1u);
            else XB_SPIN(xb_ld(&bar[XB_TOPGEN]) == tg, bar);
            __builtin_amdgcn_fence(__ATOMIC_ACQUIRE, "agent");
            xb_add(&bar[XB_XGEN(b.x)], 1u);
            asm volatile("s_waitcnt vmcnt(0)" ::: "memory");
        } else {
            XB_SPIN(xb_ld(&bar[XB_XGEN(b.x)]) == gen, bar);
            __builtin_amdgcn_fence(__ATOMIC_ACQUIRE, "agent");
            asm volatile("s_waitcnt vmcnt(0)" ::: "memory");
        }
    }
    __syncthreads();
}

namespace pg8 {
constexpr int BM = 256, BK = 64, HALF = 128, HTB = HALF * BK * 2, STAGE_BYTES = 8 * HTB, NXCD = 8, WGM = 8;
__device__ __forceinline__ int lds_byte(int r, int c) { const int st = (r >> 4) * 2 + (c >> 5), rr = r & 15, cc = c & 31, ob = rr * 64 + cc * 2; return st * 1024 + (ob ^ (((ob >> 9) & 1) << 5)); }
__device__ __forceinline__ void stage_rc(int b, int& R, int& C) { const int st = b / 1024, sb = b % 1024, swz = sb ^ (((sb >> 9) & 1) << 5); R = (st >> 1) * 16 + swz / 64; C = (st & 1) * 32 + (swz % 64) / 2; }
__device__ __forceinline__ int perm32(int rho) { const int n = rho >> 4, i = rho & 15; return 8 * (i >> 2) + 4 * n + (i & 3); }
__device__ __forceinline__ int headperm(int r) { return 64 * (r >> 5) + 8 * ((r >> 2) & 3) + 4 * ((r >> 4) & 1) + (r & 3); }

struct Unit { int pm, pn, e; };

__device__ __forceinline__ bool static_order(int i, int G, int c, int nM, int nN, Unit& u) {
    const int nwg = nM * nN; const long L = (long)i * G + c; if (L >= nwg) return false;
    int wgid = (int)L; { const int q = nwg / NXCD, r = nwg % NXCD, xcd = wgid % NXCD, off = wgid / NXCD; wgid = (xcd < r ? xcd * (q + 1) : r * (q + 1) + (xcd - r) * q) + off; }
    const int nig = WGM * nN, gid = wgid / nig, fm = gid * WGM, gsz = (nM - fm) < WGM ? (nM - fm) : WGM;
    u.pm = fm + ((wgid % nig) % gsz); u.pn = (wgid % nig) / gsz; u.e = i; return true;
}

struct SchedStd {
    static constexpr bool GATHER = false;
    const char* A; const char* B; int lda, K, nM, nN, G, c;
    __device__ __forceinline__ bool next(int i, Unit& u) const { return static_order(i, G, c, nM, nN, u); }
    __device__ __forceinline__ const char* a_base(const Unit& u) const { return A + (size_t)u.pm * 256 * lda * 2; }
    __device__ __forceinline__ const char* b_base(const Unit& u) const { return B + (size_t)u.pn * 256 * K * 2; }
    __device__ __forceinline__ void a_voff(const Unit&, int R0, int C0, int R1, int C1, unsigned (&vo)[2][2]) const {
        vo[0][0] = (unsigned)(R0 * lda + C0) * 2u; vo[0][1] = (unsigned)(R1 * lda + C1) * 2u;
        vo[1][0] = (unsigned)((R0 + 128) * lda + C0) * 2u; vo[1][1] = (unsigned)((R1 + 128) * lda + C1) * 2u; }
};
struct SchedMoE {
    const int* ebase; int G, c, npn, total_rt;
    __device__ __forceinline__ void init(const int* eb, int G_, int c_, int npn_) { ebase = eb; G = G_; c = c_; npn = npn_; total_rt = eb[16] >> 8; }
    __device__ __forceinline__ bool next_(int i, Unit& u) const {
        const int L = i * G + c; if (L >= total_rt * npn) return false;
        u.pm = L / npn; u.pn = L % npn; int e = 0;
#pragma unroll
        for (int j = 1; j < 16; ++j) e += (ebase[j] <= u.pm * 256) ? 1 : 0;
        u.e = e; return true; }
};
struct SchedUp : SchedMoE {
    static constexpr bool GATHER = true;
    const char* A; const char* B; const int* rowtok; int K;
    __device__ __forceinline__ bool next(int i, Unit& u) const { return next_(i, u); }
    __device__ __forceinline__ const char* a_base(const Unit&) const { return A; }
    __device__ __forceinline__ const char* b_base(const Unit& u) const { return B + ((size_t)u.e * 512 + (size_t)u.pn * 256) * 1024 * 2; }
    __device__ __forceinline__ void a_voff(const Unit& u, int R0, int C0, int R1, int C1, unsigned (&vo)[2][2]) const {
        const int* rt = rowtok + u.pm * 256;
        int t00 = rt[R0], t01 = rt[R1], t10 = rt[R0 + 128], t11 = rt[R1 + 128];
        t00 = t00 < 0 ? 0 : (t00 >> 1); t01 = t01 < 0 ? 0 : (t01 >> 1); t10 = t10 < 0 ? 0 : (t10 >> 1); t11 = t11 < 0 ? 0 : (t11 >> 1);
        vo[0][0] = (unsigned)(t00 * 1024 + C0) * 2u; vo[0][1] = (unsigned)(t01 * 1024 + C1) * 2u;
        vo[1][0] = (unsigned)(t10 * 1024 + C0) * 2u; vo[1][1] = (unsigned)(t11 * 1024 + C1) * 2u; }
};
struct SchedDown : SchedMoE {
    static constexpr bool GATHER = false;
    const char* A; const char* B; int K;
    __device__ __forceinline__ bool next(int i, Unit& u) const { return next_(i, u); }
    __device__ __forceinline__ const char* a_base(const Unit& u) const { return A + (size_t)u.pm * 256 * 256 * 2; }
    __device__ __forceinline__ const char* b_base(const Unit& u) const { return B + ((size_t)u.e * 1024 + (size_t)u.pn * 256) * 256 * 2; }
    __device__ __forceinline__ void a_voff(const Unit&, int R0, int C0, int R1, int C1, unsigned (&vo)[2][2]) const {
        vo[0][0] = (unsigned)(R0 * 256 + C0) * 2u; vo[0][1] = (unsigned)(R1 * 256 + C1) * 2u;
        vo[1][0] = (unsigned)((R0 + 128) * 256 + C0) * 2u; vo[1][1] = (unsigned)((R1 + 128) * 256 + C1) * 2u; }
};

template <class Epi, class Sched>
__device__ __forceinline__ void gemm_phase(LAS unsigned char* lds, const Sched& S, const Epi& E, const int K, const int tid) {
    const int wid = __builtin_amdgcn_readfirstlane(tid >> 6), lane = tid & 63, wr = wid >> 2, wc = wid & 3, fr = lane & 15, fq = lane >> 4;
    const int nt = K / BK;
    int R0, C0, R1, C1; stage_rc(tid * 16, R0, C0); stage_rc(tid * 16 + 8192, R1, C1);
    unsigned voffB[2];
    { const int Rb0 = Epi::BMODE == 1 ? ((R0 & ~31) + perm32(R0 & 31)) : Epi::BMODE == 2 ? headperm(R0) : R0;
      const int Rb1 = Epi::BMODE == 1 ? ((R1 & ~31) + perm32(R1 & 31)) : Epi::BMODE == 2 ? headperm(R1) : R1;
      voffB[0] = (unsigned)(Rb0 * K + C0) * 2u; voffB[1] = (unsigned)(Rb1 * K + C1) * 2u; }
    const size_t kstep = (size_t)(BK * 2);
    const size_t hstepB = (size_t)(Epi::BMODE == 2 ? 32 : HALF) * K * 2;
    const unsigned ldsw = (unsigned)wid * 1024u;
    const int aoff = lds_byte(wr * 64 + fr, fq * 8), boff = lds_byte(wc * 32 + fr, fq * 8);
#define PG8_SA(b, h) (((b) * 2 + (h)) * HTB)
#define PG8_SB(b, h) ((4 + (b) * 2 + (h)) * HTB)
#define PG8_STAGE(bufoff, gbase, voff) do { _Pragma("unroll") for (int _i = 0; _i < 2; ++_i) \
        __builtin_amdgcn_global_load_lds((const unsigned*)((const char*)(gbase) + (voff)[_i]), (LAS unsigned*)(lds + (bufoff) + ldsw + _i * 8192), 16, 0, 0); } while (0)
#define PG8_LDA(dst, b, h) do { _Pragma("unroll") for (int m = 0; m < 4; ++m) _Pragma("unroll") for (int k = 0; k < 2; ++k) dst[m][k] = *(const LAS bf16x8*)(lds + PG8_SA(b, h) + aoff + m * 2048 + k * 1024); } while (0)
#define PG8_LDB(dst, b, h) do { _Pragma("unroll") for (int n = 0; n < 2; ++n) _Pragma("unroll") for (int k = 0; k < 2; ++k) dst[n][k] = *(const LAS bf16x8*)(lds + PG8_SB(b, h) + boff + n * 2048 + k * 1024); } while (0)
#define PG8_MMA(ai, bj, At, Bt) do { __builtin_amdgcn_s_setprio(1); _Pragma("unroll") for (int m = 0; m < 4; ++m) _Pragma("unroll") for (int n = 0; n < 2; ++n) _Pragma("unroll") for (int k = 0; k < 2; ++k) \
        acc[ai][bj][m][n] = __builtin_amdgcn_mfma_f32_16x16x32_bf16(Bt[n][k], At[m][k], acc[ai][bj][m][n], 0, 0, 0); __builtin_amdgcn_s_setprio(0); } while (0)
#define PG8_WAIT_V(n) asm volatile("s_waitcnt vmcnt(" #n ")" ::: "memory")
#define PG8_WAIT_L(n) asm volatile("s_waitcnt lgkmcnt(" #n ")" ::: "memory")
#define PG8_BAR __builtin_amdgcn_s_barrier()
#define PG8_SCHED __builtin_amdgcn_sched_barrier(0)
    Unit cur, nxt; int ui = 0;
    if (!S.next(0, cur)) return;
    f32x4 acc[2][2][4][2];
#pragma unroll
    for (int a = 0; a < 2; ++a)
#pragma unroll
        for (int b = 0; b < 2; ++b)
#pragma unroll
            for (int m = 0; m < 4; ++m)
#pragma unroll
                for (int n = 0; n < 2; ++n) acc[a][b][m][n] = (f32x4){0.f, 0.f, 0.f, 0.f};
    bf16x8 At[4][2], B0[2][2], B1[2][2];
    const char* cA = S.a_base(cur); const char* cB = S.b_base(cur);
    unsigned voC[2][2], voN[2][2];
    S.a_voff(cur, R0, C0, R1, C1, voC);
    PG8_STAGE(PG8_SB(0, 0), cB, voffB); PG8_STAGE(PG8_SB(0, 1), cB + hstepB, voffB); PG8_STAGE(PG8_SA(0, 0), cA, voC[0]); PG8_STAGE(PG8_SA(0, 1), cA, voC[1]);
    if (wr == 1) PG8_BAR;
    PG8_WAIT_V(2); PG8_BAR;
    PG8_STAGE(PG8_SB(1, 0), cB + kstep, voffB); PG8_STAGE(PG8_SA(1, 0), cA + kstep, voC[0]); PG8_STAGE(PG8_SB(1, 1), cB + hstepB + kstep, voffB);
    PG8_WAIT_V(6); PG8_BAR;
    for (;;) {
        const bool has_next = S.next(ui + 1, nxt);
        const char* nA = has_next ? S.a_base(nxt) : cA; const char* nB = has_next ? S.b_base(nxt) : cB;
        if constexpr (Sched::GATHER) {
            if (has_next) { int t2 = tid; asm volatile("" : "+v"(t2));
                int Ra, Ca, Rb_, Cb_; stage_rc(t2 * 16, Ra, Ca); stage_rc(t2 * 16 + 8192, Rb_, Cb_); S.a_voff(nxt, Ra, Ca, Rb_, Cb_, voN); }
            else {
#pragma unroll
                for (int h = 0; h < 2; ++h)
#pragma unroll
                    for (int i = 0; i < 2; ++i) voN[h][i] = voC[h][i]; } }
#pragma unroll 1
        for (int t = 0; t < nt; t += 2) {
            const bool last = (t == nt - 2);
            const char* a1 = cA + (size_t)(t + 1) * kstep;
            const char* a2 = last ? nA : cA + (size_t)(t + 2) * kstep; const char* b2 = last ? nB : cB + (size_t)(t + 2) * kstep;
            const char* a3 = a2 + kstep; const char* b3 = b2 + kstep;
            PG8_LDB(B0, 0, 0); PG8_LDB(B1, 0, 1); PG8_SCHED; PG8_LDA(At, 0, 0); PG8_STAGE(PG8_SA(1, 1), a1, voC[1]);
            if constexpr (Sched::GATHER) {
#pragma unroll
                for (int h = 0; h < 2; ++h)
#pragma unroll
                    for (int i = 0; i < 2; ++i) voC[h][i] = last ? voN[h][i] : voC[h][i]; }
            PG8_WAIT_V(8); PG8_WAIT_L(0); PG8_BAR; PG8_MMA(0, 0, At, B0); PG8_MMA(0, 1, At, B1); PG8_BAR; PG8_SCHED;
            PG8_LDA(At, 0, 1); PG8_STAGE(PG8_SB(0, 0), b2, voffB); PG8_STAGE(PG8_SB(0, 1), b2 + hstepB, voffB); PG8_STAGE(PG8_SA(0, 0), a2, voC[0]);
            PG8_WAIT_V(8); PG8_WAIT_L(0); PG8_BAR; PG8_MMA(1, 0, At, B0); PG8_MMA(1, 1, At, B1); PG8_BAR; PG8_SCHED;
            PG8_LDB(B0, 1, 0); PG8_LDB(B1, 1, 1); PG8_SCHED; PG8_LDA(At, 1, 0); PG8_STAGE(PG8_SA(0, 1), a2, voC[1]);
            PG8_WAIT_V(8); PG8_WAIT_L(0); PG8_BAR; PG8_MMA(0, 0, At, B0); PG8_MMA(0, 1, At, B1); PG8_BAR; PG8_SCHED;
            PG8_LDA(At, 1, 1); PG8_STAGE(PG8_SB(1, 0), b3, voffB); PG8_STAGE(PG8_SB(1, 1), b3 + hstepB, voffB); PG8_STAGE(PG8_SA(1, 0), a3, voC[0]);
            PG8_WAIT_V(8); PG8_WAIT_L(0); PG8_BAR; PG8_MMA(1, 0, At, B0); PG8_MMA(1, 1, At, B1); PG8_BAR; PG8_SCHED;
        }
        if (wr == 0) PG8_BAR;
        { int fr_e = fr, fq_e = fq; asm volatile("" : "+v"(fr_e), "+v"(fq_e));
          E(acc, cur, wr, wc, fr_e, fq_e); }
        if (!has_next) break;
#pragma unroll
        for (int a = 0; a < 2; ++a)
#pragma unroll
            for (int b = 0; b < 2; ++b)
#pragma unroll
                for (int m = 0; m < 4; ++m)
#pragma unroll
                    for (int n = 0; n < 2; ++n) acc[a][b][m][n] = (f32x4){0.f, 0.f, 0.f, 0.f};
        cur = nxt; cA = nA; cB = nB; ++ui;
        if (wr == 1) PG8_BAR;
    }
    PG8_WAIT_V(0);
    PG8_BAR;
#undef PG8_SA
#undef PG8_SB
#undef PG8_STAGE
#undef PG8_LDA
#undef PG8_LDB
#undef PG8_MMA
#undef PG8_WAIT_V
#undef PG8_WAIT_L
#undef PG8_BAR
#undef PG8_SCHED
}

typedef f32x4 Acc[2][2][4][2];

struct EpiInProj {
    static constexpr int BMODE = 2;
    bf16_t* out; int ldo; const LAS float* rtab; const float* g0; const float* g1; int odd;
    __device__ __forceinline__ void operator()(const Acc& acc, const Unit& u, int wr, int wc, int fr, int fq) const {
        int mode; const float* gp = g0; float sc = 1.0f;
        if (odd) { mode = u.pn < 2 ? 3 : (u.pn < 4 ? 3 : 0); if (u.pn < 2) { gp = g0; sc = QSCALE; } else { gp = g1; sc = 1.0f; } }
        else { mode = u.pn < 2 ? 1 : (u.pn < 4 ? 2 : (u.pn < 6 ? 4 : 0)); sc = mode == 4 ? QSCALE : 1.0f; gp = g0 + (((u.pn - 2) & 1) * 4 + wc) * 64; }
        f32x4 gv[2][2];
        if (mode == 2 || mode == 3) {
#pragma unroll
            for (int bj = 0; bj < 2; ++bj)
#pragma unroll
                for (int n = 0; n < 2; ++n) gv[bj][n] = *(const f32x4*)(gp + 32 * bj + 8 * fq + 4 * n) * sc;
        } else {
#pragma unroll
            for (int bj = 0; bj < 2; ++bj)
#pragma unroll
                for (int n = 0; n < 2; ++n) gv[bj][n] = (f32x4){1.f, 1.f, 1.f, 1.f};
        }
#pragma unroll
        for (int ai = 0; ai < 2; ++ai)
#pragma unroll
            for (int m = 0; m < 4; ++m) {
                const int row = u.pm * 256 + ai * 128 + wr * 64 + m * 16 + fr;
                const float rs = rtab[u.e * 256 + ai * 128 + wr * 64 + m * 16 + fr];
                f32x4 v[2][2];
#pragma unroll
                for (int bj = 0; bj < 2; ++bj)
#pragma unroll
                    for (int n = 0; n < 2; ++n) v[bj][n] = acc[ai][bj][m][n] * rs;
                if (mode == 1 || mode == 2) {
#pragma unroll
                    for (int bj = 0; bj < 2; ++bj)
#pragma unroll
                        for (int n = 0; n < 2; ++n)
#pragma unroll
                            for (int e = 0; e < 4; ++e) v[bj][n][e] = gelu_tanh(v[bj][n][e]);
                }
                if (mode == 2 || mode == 3) {
                    float q = 0.f;
#pragma unroll
                    for (int bj = 0; bj < 2; ++bj)
#pragma unroll
                        for (int n = 0; n < 2; ++n) q += (v[bj][n][0] * v[bj][n][0] + v[bj][n][1] * v[bj][n][1]) + (v[bj][n][2] * v[bj][n][2] + v[bj][n][3] * v[bj][n][3]);
                    q = sum_x32(sum_x16(q));
                    const float hr = 1.0f / sqrtf(q * (1.0f / 64.0f) + EPS);
#pragma unroll
                    for (int bj = 0; bj < 2; ++bj)
#pragma unroll
                        for (int n = 0; n < 2; ++n) v[bj][n] = v[bj][n] * hr * gv[bj][n];
                } else if (mode == 4) {
#pragma unroll
                    for (int bj = 0; bj < 2; ++bj)
#pragma unroll
                        for (int n = 0; n < 2; ++n) v[bj][n] = v[bj][n] * sc;
                }
                bf16_t* rowp = out + (size_t)row * ldo + u.pn * 256 + wc * 64 + 8 * fq;
#pragma unroll
                for (int bj = 0; bj < 2; ++bj) {
                    u32x4 w; w.x = cvt_pk_bf16(v[bj][0][0], v[bj][0][1]); w.y = cvt_pk_bf16(v[bj][0][2], v[bj][0][3]); w.z = cvt_pk_bf16(v[bj][1][0], v[bj][1][1]); w.w = cvt_pk_bf16(v[bj][1][2], v[bj][1][3]);
                    *(u32x4*)(rowp + 32 * bj) = w; }
            }
    }
};

struct EpiResid {
    static constexpr int BMODE = 1;
    const bf16_t* hin; bf16_t* hb; float* ss;
    __device__ __forceinline__ void operator()(const Acc& acc, const Unit& u, int wr, int wc, int fr, int fq) const {
#pragma unroll
        for (int ai = 0; ai < 2; ++ai) {
            u32x4 hw[4][2];
#pragma unroll
            for (int m = 0; m < 4; ++m)
#pragma unroll
                for (int bj = 0; bj < 2; ++bj) hw[m][bj] = *(const u32x4*)(hin + (size_t)(u.pm * 256 + ai * 128 + wr * 64 + m * 16 + fr) * D + u.pn * 256 + bj * 128 + wc * 32 + 8 * fq);
            __builtin_amdgcn_sched_barrier(0);
#pragma unroll
            for (int m = 0; m < 4; ++m) {
                const int row = u.pm * 256 + ai * 128 + wr * 64 + m * 16 + fr; float q = 0.f;
#pragma unroll
                for (int bj = 0; bj < 2; ++bj) {
                    const size_t off = (size_t)row * D + u.pn * 256 + bj * 128 + wc * 32 + 8 * fq; const u32x4 h4 = hw[m][bj];
                    const f32x4 v0 = (f32x4){bf_lo(h4.x), bf_hi(h4.x), bf_lo(h4.y), bf_hi(h4.y)} + acc[ai][bj][m][0], v1 = (f32x4){bf_lo(h4.z), bf_hi(h4.z), bf_lo(h4.w), bf_hi(h4.w)} + acc[ai][bj][m][1];
                    u32x4 w; w.x = cvt_pk_bf16(v0[0], v0[1]); w.y = cvt_pk_bf16(v0[2], v0[3]); w.z = cvt_pk_bf16(v1[0], v1[1]); w.w = cvt_pk_bf16(v1[2], v1[3]);
                    *(u32x4*)(hb + off) = w;
                    q += (v0[0] * v0[0] + v0[1] * v0[1]) + (v0[2] * v0[2] + v0[3] * v0[3]) + (v1[0] * v1[0] + v1[1] * v1[1]) + (v1[2] * v1[2] + v1[3] * v1[3]); }
                q = sum_x32(sum_x16(q));
                if (fq == 0) ss[(size_t)row * 16 + u.pn * 4 + wc] = q;
            }
        }
    }
};
struct EpiPle {
    static constexpr int BMODE = 1;
    const bf16_t* h; bf16_t* xn; float* fout; float* ss; const float* rstd2; const float* rstdE; const bf16_t* eraw; const float* gE;
    __device__ __forceinline__ void operator()(const Acc& acc, const Unit& u, int wr, int wc, int fr, int fq) const {
        f32x4 gv[2][2];
#pragma unroll
        for (int bj = 0; bj < 2; ++bj)
#pragma unroll
            for (int n = 0; n < 2; ++n) gv[bj][n] = *(const f32x4*)(gE + u.pn * 256 + bj * 128 + wc * 32 + 8 * fq + 4 * n);
#pragma unroll
        for (int ap = 0; ap < 4; ++ap) { const int ai = ap >> 1, m0 = (ap & 1) * 2;
            u32x4 ewv[4][2], hwv[4][2]; float r2v[4], rEv[4];
#pragma unroll
            for (int m = m0; m < m0 + 2; ++m) { const int row = u.pm * 256 + ai * 128 + wr * 64 + m * 16 + fr; r2v[m] = rstd2[row]; rEv[m] = rstdE[row];
#pragma unroll
                for (int bj = 0; bj < 2; ++bj) { const size_t off = (size_t)row * D + u.pn * 256 + bj * 128 + wc * 32 + 8 * fq; ewv[m][bj] = *(const u32x4*)(eraw + off); hwv[m][bj] = *(const u32x4*)(h + off); } }
            __builtin_amdgcn_sched_barrier(0);
#pragma unroll
            for (int m = m0; m < m0 + 2; ++m) {
                const int row = u.pm * 256 + ai * 128 + wr * 64 + m * 16 + fr; float q = 0.f;
                const float r2 = r2v[m], rE = rEv[m];
#pragma unroll
                for (int bj = 0; bj < 2; ++bj) {
                    const size_t off = (size_t)row * D + u.pn * 256 + bj * 128 + wc * 32 + 8 * fq;
                    const u32x4 ew = ewv[m][bj], hw = hwv[m][bj];
                    f32x4 e0 = (f32x4){bf_lo(ew.x), bf_hi(ew.x), bf_lo(ew.y), bf_hi(ew.y)}, e1 = (f32x4){bf_lo(ew.z), bf_hi(ew.z), bf_lo(ew.w), bf_hi(ew.w)};
                    e0 = e0 * rE * gv[bj][0]; e1 = e1 * rE * gv[bj][1];
                    f32x4 g0, g1;
#pragma unroll
                    for (int e = 0; e < 4; ++e) { g0[e] = sigmoid_f(acc[ai][bj][m][0][e] * r2); g1[e] = sigmoid_f(acc[ai][bj][m][1][e] * r2); }
                    const f32x4 v0 = (f32x4){bf_lo(hw.x), bf_hi(hw.x), bf_lo(hw.y), bf_hi(hw.y)} + g0 * e0, v1 = (f32x4){bf_lo(hw.z), bf_hi(hw.z), bf_lo(hw.w), bf_hi(hw.w)} + g1 * e1;
                    if (fout) { *(f32x4*)(fout + off) = v0; *(f32x4*)(fout + off + 4) = v1; }
                    else { u32x4 w; w.x = cvt_pk_bf16(v0[0], v0[1]); w.y = cvt_pk_bf16(v0[2], v0[3]); w.z = cvt_pk_bf16(v1[0], v1[1]); w.w = cvt_pk_bf16(v1[2], v1[3]);
                        *(u32x4*)(xn + off) = w; }
                    q += (v0[0] * v0[0] + v0[1] * v0[1]) + (v0[2] * v0[2] + v0[3] * v0[3]) + (v1[0] * v1[0] + v1[1] * v1[1]) + (v1[2] * v1[2] + v1[3] * v1[3]); }
                q = sum_x32(sum_x16(q));
                if (fq == 0) ss[(size_t)row * 16 + u.pn * 4 + wc] = q;
            }
        }
    }
};
struct EpiEproj {
    static constexpr int BMODE = 1;
    bf16_t* eraw; float* ss;
    __device__ __forceinline__ void operator()(const Acc& acc, const Unit& u, int wr, int wc, int fr, int fq) const {
#pragma unroll
        for (int ai = 0; ai < 2; ++ai)
#pragma unroll
            for (int m = 0; m < 4; ++m) {
                const int row = u.pm * 256 + ai * 128 + wr * 64 + m * 16 + fr; float q = 0.f;
#pragma unroll
                for (int bj = 0; bj < 2; ++bj) {
                    const size_t off = (size_t)row * D + u.pn * 256 + bj * 128 + wc * 32 + 8 * fq;
                    const f32x4 v0 = acc[ai][bj][m][0], v1 = acc[ai][bj][m][1];
                    u32x4 w; w.x = cvt_pk_bf16(v0[0], v0[1]); w.y = cvt_pk_bf16(v0[2], v0[3]); w.z = cvt_pk_bf16(v1[0], v1[1]); w.w = cvt_pk_bf16(v1[2], v1[3]);
                    *(u32x4*)(eraw + off) = w;
                    q += (v0[0] * v0[0] + v0[1] * v0[1]) + (v0[2] * v0[2] + v0[3] * v0[3]) + (v1[0] * v1[0] + v1[1] * v1[1]) + (v1[2] * v1[2] + v1[3] * v1[3]); }
                q = sum_x32(sum_x16(q));
                if (fq == 0) ss[(size_t)row * 16 + u.pn * 4 + wc] = q;
            }
    }
};
struct EpiUp {
    static constexpr int BMODE = 1;
    bf16_t* act; const int* rowtok; const float* roww; const float* rowrs;
    __device__ __forceinline__ void operator()(const Acc& acc, const Unit& u, int wr, int wc, int fr, int fq) const {
        int tk[2][4]; float rsv[2][4], gwv[2][4];
#pragma unroll
        for (int ai = 0; ai < 2; ++ai)
#pragma unroll
            for (int m = 0; m < 4; ++m) { const int sr = u.pm * 256 + ai * 128 + wr * 64 + m * 16 + fr; tk[ai][m] = rowtok[sr]; rsv[ai][m] = rowrs[sr]; gwv[ai][m] = roww[sr]; }
        __builtin_amdgcn_sched_barrier(0);
#pragma unroll
        for (int ai = 0; ai < 2; ++ai)
#pragma unroll
            for (int m = 0; m < 4; ++m) {
                const int sr = u.pm * 256 + ai * 128 + wr * 64 + m * 16 + fr;
                if (tk[ai][m] < 0) continue;
                const float rs = rsv[ai][m], gw = gwv[ai][m];
                float o[8];
#pragma unroll
                for (int n = 0; n < 2; ++n)
#pragma unroll
                    for (int e = 0; e < 4; ++e) { const float g = acc[ai][0][m][n][e] * rs, uu = acc[ai][1][m][n][e] * rs; o[4 * n + e] = g * sigmoid_f(g) * uu * gw; }
                u32x4 w; w.x = cvt_pk_bf16(o[0], o[1]); w.y = cvt_pk_bf16(o[2], o[3]); w.z = cvt_pk_bf16(o[4], o[5]); w.w = cvt_pk_bf16(o[6], o[7]);
                *(u32x4*)(act + (size_t)sr * 256 + u.pn * 128 + wc * 32 + 8 * fq) = w;
            }
    }
};
struct EpiDown {
    static constexpr int BMODE = 1;
    bf16_t* Y; const int* rowtok;
    __device__ __forceinline__ void operator()(const Acc& acc, const Unit& u, int wr, int wc, int fr, int fq) const {
        int tk[2][4];
#pragma unroll
        for (int ai = 0; ai < 2; ++ai)
#pragma unroll
            for (int m = 0; m < 4; ++m) tk[ai][m] = rowtok[u.pm * 256 + ai * 128 + wr * 64 + m * 16 + fr];
        __builtin_amdgcn_sched_barrier(0);
#pragma unroll
        for (int ai = 0; ai < 2; ++ai)
#pragma unroll
            for (int m = 0; m < 4; ++m) {
                const int it = tk[ai][m];
                if (it < 0) continue;
                bf16_t* rowp = Y + ((size_t)(it & 1) * T + (size_t)(it >> 1)) * D + u.pn * 256 + wc * 32 + 8 * fq;
#pragma unroll
                for (int bj = 0; bj < 2; ++bj) {
                    const f32x4 v0 = acc[ai][bj][m][0], v1 = acc[ai][bj][m][1];
                    u32x4 w; w.x = cvt_pk_bf16(v0[0], v0[1]); w.y = cvt_pk_bf16(v0[2], v0[3]); w.z = cvt_pk_bf16(v1[0], v1[1]); w.w = cvt_pk_bf16(v1[2], v1[3]);
                    *(u32x4*)(rowp + bj * 128) = w; }
            }
    }
};
}

#include <hip/hip_bf16.h>
#include <cmath>
namespace attn_body {
using bf16=__hip_bfloat16;
using bf16x8=__attribute__((ext_vector_type(8)))short;
using s16x4=__attribute__((ext_vector_type(4)))short;
using f32x16=__attribute__((ext_vector_type(16)))float;
using f32x4=__attribute__((ext_vector_type(4)))float;
using u32x4=__attribute__((ext_vector_type(4)))unsigned;
using u32x2=__attribute__((ext_vector_type(2)))unsigned;
constexpr int BATCH=8,NHEAD=8,SEQ=4096,D=64,DM=2048,DMO=1024;
constexpr int NW=8,QBLK=32,QB=QBLK*NW,KVBLK=64,NQB=SEQ/QB;
constexpr int ATTN_UNIT_ROWS=QB;
__device__ __forceinline__ int crow(int r,int hi){return (r&3)+8*(r>>2)+4*hi;}
#define SBAR() __builtin_amdgcn_sched_barrier(0)
__device__ __forceinline__ void cmask(f32x16&p0,f32x16&p1,int jb,int qrel,int hi){
  const float NEG=-INFINITY; const int lim=qrel-(64*jb+4*hi);
  #pragma unroll
  for(int r=0;r<16;++r){const int kc=(r&3)+8*(r>>2); if(kc>lim)p0[r]=NEG; if(kc+32>lim)p1[r]=NEG;}
}

constexpr int NSLOT=3, SLOTB=8192;
constexpr int LDS_K=0, LDS_V=NSLOT*SLOTB, LDS_WS=2*NSLOT*SLOTB, LDS_OST=LDS_WS+NW*64*4, LDS_BYTES=LDS_OST+NW*4096;
constexpr float C2=0.125f*1.4426950408889634f;
__device__ __forceinline__ void glds16(const void*gsrc,unsigned lds_dst){unsigned keep;
  asm volatile("s_mov_b32 %0, m0\n\ts_mov_b32 m0, %2\n\ts_nop 0\n\tglobal_load_lds_dwordx4 %1, off\n\ts_mov_b32 m0, %0":"=&s"(keep):"v"(gsrc),"s"(lds_dst):"memory");}
__device__ __forceinline__ float max3f(float a,float b,float c){float r;asm("v_max3_f32 %0, %1, %2, %3":"=v"(r):"v"(a),"v"(b),"v"(c));return r;}
__device__ __forceinline__ float max2f(float a,float b){float r;asm("v_max_f32_e32 %0, %1, %2":"=v"(r):"v"(a),"v"(b));return r;}
__device__ __forceinline__ float fadd_s(float a,float b){float r;asm("v_add_f32_e32 %0, %1, %2":"=v"(r):"v"(a),"v"(b));return r;}
__device__ __forceinline__ float fsub_s(float a,float b){float r;asm("v_sub_f32_e32 %0, %1, %2":"=v"(r):"v"(a),"v"(b));return r;}
typedef float f32x2_t __attribute__((ext_vector_type(2))); typedef __bf16 bf16x2_t __attribute__((ext_vector_type(2)));
__device__ __forceinline__ unsigned cvtpk_s(float lo,float hi){f32x2_t v={lo,hi};bf16x2_t b=__builtin_convertvector(v,bf16x2_t);return __builtin_bit_cast(unsigned,b);}
#define WAIT_BAR(N) asm volatile("s_waitcnt vmcnt(" #N ") lgkmcnt(0)\n\ts_barrier":::"memory")

__device__ __forceinline__ void qkt(f32x16&p0,f32x16&p1,const char*Kslot,const bf16x8*qr,int r32,int hi,bf16x8 ka0,bf16x8 ka1,bf16x8 qaug){
  const char*kb=Kslot+hi*1024+r32*16;
  p0=__builtin_amdgcn_mfma_f32_32x32x16_bf16(ka0,qaug,f32x16{},0,0,0);p1=__builtin_amdgcn_mfma_f32_32x32x16_bf16(ka1,qaug,f32x16{},0,0,0);
  #pragma unroll
  for(int d0=0;d0<4;++d0){
    const bf16x8 b0=*reinterpret_cast<const bf16x8*>(kb+d0*2048);
    const bf16x8 b1=*reinterpret_cast<const bf16x8*>(kb+d0*2048+512);
    p0=__builtin_amdgcn_mfma_f32_32x32x16_bf16(b0,qr[d0],p0,0,0,0);p1=__builtin_amdgcn_mfma_f32_32x32x16_bf16(b1,qr[d0],p1,0,0,0);}
}
typedef __attribute__((address_space(3))) const char* lds_cptr;
typedef short v4i16_t __attribute__((ext_vector_type(4)));
__device__ __forceinline__ void kload8(bf16x8*kf,lds_cptr kp){
  kf[0]=*(const __attribute__((address_space(3))) bf16x8*)(kp);      kf[1]=*(const __attribute__((address_space(3))) bf16x8*)(kp+512);
  kf[2]=*(const __attribute__((address_space(3))) bf16x8*)(kp+2048); kf[3]=*(const __attribute__((address_space(3))) bf16x8*)(kp+2560);
  kf[4]=*(const __attribute__((address_space(3))) bf16x8*)(kp+4096); kf[5]=*(const __attribute__((address_space(3))) bf16x8*)(kp+4608);
  kf[6]=*(const __attribute__((address_space(3))) bf16x8*)(kp+6144); kf[7]=*(const __attribute__((address_space(3))) bf16x8*)(kp+6656);
}
__device__ __forceinline__ void kload2(bf16x8*kf,lds_cptr kp,int j){ kf[2*j]=*(const __attribute__((address_space(3))) bf16x8*)(kp+j*2048); kf[2*j+1]=*(const __attribute__((address_space(3))) bf16x8*)(kp+j*2048+512); }
__device__ __forceinline__ s16x4 vtr(lds_cptr p){ return __builtin_bit_cast(s16x4,__builtin_amdgcn_ds_read_tr16_b64_v4i16((__attribute__((address_space(3))) v4i16_t*)p)); }
__device__ __forceinline__ float rowmax(const f32x16&p0,const f32x16&p1){
  float a=max3f(p0[0],p0[1],p1[0]),b=max3f(p0[2],p0[3],p1[1]);a=max3f(a,p1[2],p1[3]);
  #pragma unroll
  for(int r=4;r<16;r+=4){a=max3f(a,p0[r],p0[r+1]);b=max3f(b,p0[r+2],p0[r+3]);a=max3f(a,p1[r],p1[r+1]);b=max3f(b,p1[r+2],p1[r+3]);}
  const float m=max2f(a,b);
  auto rr=__builtin_amdgcn_permlane32_swap(__float_as_uint(m),__float_as_uint(m),false,false);
  return max2f(__uint_as_float(rr[0]),__uint_as_float(rr[1]));
}
__device__ __forceinline__ void pv(f32x16*o,int vb,bf16x8 pa0,bf16x8 pa1,bf16x8 pa2,bf16x8 pa3){
  #pragma unroll
  for(int d0=0;d0<2;++d0){s16x4 lo[4],hi[4];
    #pragma unroll
    for(int ks=0;ks<4;++ks){
      asm volatile("ds_read_b64_tr_b16 %0,%1 offset:%c2":"=&v"(lo[ks]):"v"(vb),"i"(d0*4096+ks*1024):"memory");
      asm volatile("ds_read_b64_tr_b16 %0,%1 offset:%c2":"=&v"(hi[ks]):"v"(vb),"i"(d0*4096+ks*1024+512):"memory");}
    asm volatile("s_waitcnt lgkmcnt(0)":::"memory");SBAR();
    #define PK(k) (bf16x8){lo[k][0],lo[k][1],lo[k][2],lo[k][3],hi[k][0],hi[k][1],hi[k][2],hi[k][3]}
    o[d0]=__builtin_amdgcn_mfma_f32_32x32x16_bf16(pa0,PK(0),o[d0],0,0,0);
    o[d0]=__builtin_amdgcn_mfma_f32_32x32x16_bf16(pa1,PK(1),o[d0],0,0,0);
    o[d0]=__builtin_amdgcn_mfma_f32_32x32x16_bf16(pa2,PK(2),o[d0],0,0,0);
    o[d0]=__builtin_amdgcn_mfma_f32_32x32x16_bf16(pa3,PK(3),o[d0],0,0,0);
    #undef PK
  }
}

#ifndef ATTN_STORE16
#define ATTN_STORE16(p,v) (*(u32x4*)(p)=(v))
#endif
template<int THRL> __device__ __forceinline__ void attn_unit(int b,int h,int qb,const bf16*Q,const bf16*__restrict__ K,const bf16*__restrict__ V,bf16*O,char*shm,const char*kaug,const int tid,const int tstart){
  const int lane=tid&63,r32=lane&31,hi=lane>>5; const int wid=__builtin_amdgcn_readfirstlane(tid>>6);
  const long rowbase=(long)b*SEQ; const int q0=qb*QB;
  const bf16*Qw=Q+(rowbase+q0+wid*QBLK)*DM+h*D;
  const bf16*Kh=K+(rowbase+(long)tstart*KVBLK)*DM+h*D,*Vh=V+(rowbase+(long)tstart*KVBLK)*DM+h*D;
  const unsigned lds0=(unsigned)(uintptr_t)shm;
  float*wsf=(float*)(shm+LDS_WS)+wid*64;
  const float*wsfh=wsf+4*hi;
  const bf16*ksrc=Kh+(long)lane*DM+wid*8;
  const bf16*vsrc=Vh+(long)(16*(wid&3)+(lane>>2))*DM+(wid>>2)*32+(lane&3)*8;
  const unsigned kdst=lds0+LDS_K+wid*1024, vdst=lds0+LDS_V+wid*1024;
  #define DMA_K(t,slot) glds16(ksrc+(long)(t)*KVBLK*DM,(unsigned)__builtin_amdgcn_readfirstlane(kdst+(slot)))
  #define DMA_V(t,slot) glds16(vsrc+(long)(t)*KVBLK*DM,(unsigned)__builtin_amdgcn_readfirstlane(vdst+(slot)))
  const int vb0=(int)(lds0+LDS_V)+((lane>>4)&1)*32+(lane&3)*8+(4*hi+((lane&15)>>2))*64;
  const char*Kbase=shm+LDS_K; bf16x8 kf[8];
  const lds_cptr shm3=(lds_cptr)shm; const lds_cptr kp0=shm3+LDS_K+hi*1024+r32*16; const lds_cptr vp0=shm3+LDS_V+((lane>>4)&1)*32+(lane&3)*8+(4*hi+((lane&15)>>2))*64;
  const int NT=(q0+QB)/KVBLK-tstart;
  kaug+=8*KVBLK*tstart;
  DMA_K(0,0);DMA_V(0,0);DMA_K(1,SLOTB);
  bf16x8 qr[4];
  #pragma unroll
  for(int d0=0;d0<4;++d0)qr[d0]=*reinterpret_cast<const bf16x8*>(&Qw[(long)r32*DM+d0*16+hi*8]);
  float mhat=0.f,l_reg=0.f;f32x16 o[2];o[0]=f32x16{};o[1]=f32x16{};
  const int qrel=wid*QBLK+r32;
  #define CMASK(P0,P1,t) do{int jb_=(t)-(NT-4); if(jb_>=0)cmask(P0,P1,jb_,qrel,hi);}while(0)
  #define KAUG(t,kb_) ({ const u32x2 rc_=*(const u32x2*)(kaug+(KVBLK*(t)+32*(kb_)+r32)*8); u32x4 w_; w_.x=hi?0u:rc_.x; w_.y=hi?0u:((rc_.y&0xffffu)|0xBF800000u); w_.z=hi?0u:0xBF80BF80u; w_.w=0u; __builtin_bit_cast(bf16x8,w_); })
  bf16x8 qaug;
  #define QAUG() do{ const unsigned ph_=cvtpk_s(mhat,0.f)&0xffffu; const float r1_=mhat-__uint_as_float(ph_<<16); const unsigned pm_=cvtpk_s(r1_,0.f)&0xffffu; const float r2_=r1_-__uint_as_float(pm_<<16); \
      const unsigned pl_=cvtpk_s(r2_,0.f)&0xffffu; u32x4 w_; w_.x=hi?0u:0x3F803F80u; w_.y=hi?0u:(0x3F80u|(ph_<<16)); w_.z=hi?0u:(pm_|(pl_<<16)); w_.w=0u; qaug=__builtin_bit_cast(bf16x8,w_); }while(0)
  bool resc=false;
  #define START(P0,P1) do{ const float rm=rowmax(P0,P1); resc=false; \
    { const float dl=rm; mhat=fadd_s(mhat,dl); QAUG(); \
      _Pragma("unroll") for(int r=0;r<16;++r){P0[r]=fsub_s(P0[r],dl);P1[r]=fsub_s(P1[r],dl);} \
      } \
    _Pragma("unroll") for(int r=0;r<16;++r)P0[r]=__builtin_amdgcn_exp2f(P0[r]); }while(0)
  #define RESC() do{ if(resc){ asm volatile("s_waitcnt lgkmcnt(0)":::"memory"); \
      _Pragma("unroll") for(int d_=0;d_<2;++d_) _Pragma("unroll") for(int r=0;r<16;++r)o[d_][r]*=wsfh[(r&3)+8*(r>>2)]; } }while(0)
  f32x16 pA0,pA1,pB0,pB1;
  int sl_prev=0,sl_cur=0,sl_next=SLOTB;
  #define ROT() do{sl_prev=sl_cur;sl_cur=sl_next;sl_next=(sl_next==(NSLOT-1)*SLOTB)?0:sl_next+SLOTB;}while(0)
  DMA_K(2,2*SLOTB);
  WAIT_BAR(3);
  QAUG(); qkt(pA0,pA1,Kbase,qr,r32,hi,KAUG(0,0),KAUG(0,1),qaug);asm volatile("s_nop 15\n\ts_nop 7":"+v"(pA0),"+v"(pA1));CMASK(pA0,pA1,0);
  START(pA0,pA1);
  _Pragma("unroll") for(int r=0;r<16;++r)pA1[r]=__builtin_amdgcn_exp2f(pA1[r]);
  WAIT_BAR(0);
  DMA_K(3,0);DMA_V(1,SLOTB);
  ROT();
  kload8(kf,kp0+sl_cur);
  WAIT_BAR(2);
  s16x4 vlo[8],vhi[8]; u32x4 pw0,pw1,pw2,pw3;
  #define PKW(P,B) cvtpk_s(P[B],P[B+1])
  #define PAF(k) __builtin_bit_cast(bf16x8,pw##k)
  #define VFR(i) (bf16x8){vlo[i][0],vlo[i][1],vlo[i][2],vlo[i][3],vhi[i][0],vhi[i][1],vhi[i][2],vhi[i][3]}
  #define PIN(x) asm volatile("":"+v"(x))
  #define MX3(a,b,c) __builtin_fmaxf(__builtin_fmaxf((a),(b)),(c))
  #define GAPA(MF,A0,A1,A2,A3,W0,W1,PW) do{ MF; sacc+=A0; sacc+=A1; sacc+=A2; sacc+=A3; PIN(sacc); W0; W1; PIN(PW); SBAR(); }while(0)
  #define EX(v) __builtin_amdgcn_exp2f(v)
  #define GAPB(MF,X,B) do{ MF; X[B]=EX(X[B]); X[B+1]=EX(X[B+1]); X[B+2]=EX(X[B+2]); X[B+3]=EX(X[B+3]); PIN(X); SBAR(); }while(0)
  #define VRD(i) do{ vlo[i]=vtr(vp_+(((i)>>2)*4096+((i)&3)*1024)); vhi[i]=vtr(vp_+(((i)>>2)*4096+((i)&3)*1024+512)); }while(0)
  #define KRD(G,j) do{ if(G){ kload2(kf,kp0+sl_next,j); SBAR(); } }while(0)
  #define STEP(C0,C1,P0,P1,t,GK,GV,GL) do{ SBAR(); \
    const lds_cptr vp_=vp0+sl_prev; \
    { const bf16x8 ka0_=KAUG(t,0), ka1_=KAUG(t,1); C0=__builtin_amdgcn_mfma_f32_32x32x16_bf16(ka0_,qaug,f32x16{},0,0,0); C1=__builtin_amdgcn_mfma_f32_32x32x16_bf16(ka1_,qaug,f32x16{},0,0,0); SBAR(); } \
    VRD(0); SBAR(); float sacc=(P0[0]+P0[1]); \
    GAPA(C0=__builtin_amdgcn_mfma_f32_32x32x16_bf16(kf[0],qr[0],C0,0,0,0), P0[2],P0[3],P0[4],P0[5],     pw0[0]=PKW(P0,0), pw0[1]=PKW(P0,2), pw0); \
    VRD(4); SBAR(); GAPA(C1=__builtin_amdgcn_mfma_f32_32x32x16_bf16(kf[1],qr[0],C1,0,0,0), P0[6],P0[7],P0[8],P0[9],     pw0[2]=PKW(P0,4), pw0[3]=PKW(P0,6), pw0); \
    VRD(1); SBAR(); GAPA(C0=__builtin_amdgcn_mfma_f32_32x32x16_bf16(kf[2],qr[1],C0,0,0,0),   P0[10],P0[11],P0[12],P0[13], pw1[0]=PKW(P0,8), pw1[1]=PKW(P0,10), pw1); \
    VRD(5); SBAR(); GAPA(C1=__builtin_amdgcn_mfma_f32_32x32x16_bf16(kf[3],qr[1],C1,0,0,0),   P0[14],P0[15],P1[0],P1[1],   pw1[2]=PKW(P0,12),pw1[3]=PKW(P0,14), pw1); \
    VRD(2); SBAR(); GAPA(C0=__builtin_amdgcn_mfma_f32_32x32x16_bf16(kf[4],qr[2],C0,0,0,0),   P1[2],P1[3],P1[4],P1[5],     pw2[0]=PKW(P1,0), pw2[1]=PKW(P1,2), pw2); \
    VRD(6); SBAR(); GAPA(C1=__builtin_amdgcn_mfma_f32_32x32x16_bf16(kf[5],qr[2],C1,0,0,0),   P1[6],P1[7],P1[8],P1[9],     pw2[2]=PKW(P1,4), pw2[3]=PKW(P1,6), pw2); \
    VRD(3); SBAR(); GAPA(C0=__builtin_amdgcn_mfma_f32_32x32x16_bf16(kf[6],qr[3],C0,0,0,0),   P1[10],P1[11],P1[12],P1[13], pw3[0]=PKW(P1,8), pw3[1]=PKW(P1,10), pw3); \
    VRD(7); SBAR(); GAPA(C1=__builtin_amdgcn_mfma_f32_32x32x16_bf16(kf[7],qr[3],C1,0,0,0),   P1[14],P1[15],0.f,0.f,       pw3[2]=PKW(P1,12),pw3[3]=PKW(P1,14), pw3); \
    l_reg+=sacc; \
    if(GK){DMA_K((t)+3,sl_cur);} if(GV){DMA_V((t)+1,sl_next);} \
    CMASK(C0,C1,t); \
    { float a=MX3(C0[0],C0[1],C1[0]),b=MX3(C0[2],C0[3],C1[1]); a=MX3(a,C1[2],C1[3]); \
      _Pragma("unroll") for(int r=4;r<16;r+=4){a=MX3(a,C0[r],C0[r+1]);b=MX3(b,C0[r+2],C0[r+3]);a=MX3(a,C1[r],C1[r+1]);b=MX3(b,C1[r+2],C1[r+3]);} \
      float rm=__builtin_fmaxf(a,b); { auto rr=__builtin_amdgcn_permlane32_swap(__float_as_uint(rm),__float_as_uint(rm),false,false); rm=__builtin_fmaxf(__uint_as_float(rr[0]),__uint_as_float(rr[1])); } \
      resc=false; \
      if(__builtin_expect(__any(rm>(float)THRL),0)){ const float dl=__builtin_fmaxf(rm,0.f); mhat+=dl; QAUG(); \
        _Pragma("unroll") for(int r=0;r<16;++r){C0[r]-=dl;C1[r]-=dl;} \
        const float f=__builtin_amdgcn_exp2f(-dl); l_reg*=f; if(hi==0)wsf[r32]=f; resc=true; } } \
    SBAR(); \
    GAPB(o[0]=__builtin_amdgcn_mfma_f32_32x32x16_bf16(PAF(0),VFR(0),o[0],0,0,0), C0,0); \
    GAPB(o[1]=__builtin_amdgcn_mfma_f32_32x32x16_bf16(PAF(0),VFR(4),o[1],0,0,0), C0,4); \
    KRD(GL,0); GAPB(o[0]=__builtin_amdgcn_mfma_f32_32x32x16_bf16(PAF(1),VFR(1),o[0],0,0,0), C0,8); \
    KRD(GL,1); GAPB(o[1]=__builtin_amdgcn_mfma_f32_32x32x16_bf16(PAF(1),VFR(5),o[1],0,0,0), C0,12); \
    KRD(GL,2); GAPB(o[0]=__builtin_amdgcn_mfma_f32_32x32x16_bf16(PAF(2),VFR(2),o[0],0,0,0), C1,0); \
    KRD(GL,3); GAPB(o[1]=__builtin_amdgcn_mfma_f32_32x32x16_bf16(PAF(2),VFR(6),o[1],0,0,0), C1,4); \
    GAPB(o[0]=__builtin_amdgcn_mfma_f32_32x32x16_bf16(PAF(3),VFR(3),o[0],0,0,0), C1,8); \
    GAPB(o[1]=__builtin_amdgcn_mfma_f32_32x32x16_bf16(PAF(3),VFR(7),o[1],0,0,0), C1,12); \
    }while(0)
  int t=1;
  #undef CMASK
  #define CMASK(P0,P1,t) do{}while(0)
  for(;t+5<NT;t+=2){
    STEP(pB0,pB1,pA0,pA1,t,true,true,true);     WAIT_BAR(2); RESC(); ROT();
    STEP(pA0,pA1,pB0,pB1,t+1,true,true,true);   WAIT_BAR(2); RESC(); ROT();
  }
  #undef CMASK
  #define CMASK(P0,P1,t) do{int jb_=(t)-(NT-4); if(jb_>=0)cmask(P0,P1,jb_,qrel,hi);}while(0)
  #define ENDW(tt) do{ if((tt)+3<NT){WAIT_BAR(2);} else if((tt)+2<NT){WAIT_BAR(1);} else {WAIT_BAR(0);} }while(0)
  for(;t+1<NT;t+=2){
    STEP(pB0,pB1,pA0,pA1,t,(t+3<NT),(t+1<NT),(t+1<NT));       ENDW(t);   RESC(); ROT();
    STEP(pA0,pA1,pB0,pB1,t+1,(t+4<NT),(t+2<NT),(t+2<NT));     ENDW(t+1); RESC(); ROT();
  }
  STEP(pB0,pB1,pA0,pA1,NT-1,false,false,false); RESC();
  { float sacc=pB0[0]+pB0[1]; _Pragma("unroll") for(int r=2;r<16;++r)sacc+=pB0[r]; _Pragma("unroll") for(int r=0;r<16;++r)sacc+=pB1[r]; l_reg+=sacc;
    pw0=(u32x4){PKW(pB0,0),PKW(pB0,2),PKW(pB0,4),PKW(pB0,6)};pw1=(u32x4){PKW(pB0,8),PKW(pB0,10),PKW(pB0,12),PKW(pB0,14)};pw2=(u32x4){PKW(pB1,0),PKW(pB1,2),PKW(pB1,4),PKW(pB1,6)};pw3=(u32x4){PKW(pB1,8),PKW(pB1,10),PKW(pB1,12),PKW(pB1,14)};
    SBAR(); pv(o,vb0+sl_cur,PAF(0),PAF(1),PAF(2),PAF(3)); }
  #undef PKW
  #undef PAF
  #undef VFR
  #undef PIN
  #undef MX3
  #undef GAPA
  #undef GAPB
  #undef EX
  #undef VRD
  #undef KRD
  #undef STEP
  #undef ENDW
  {auto rr=__builtin_amdgcn_permlane32_swap(__float_as_uint(l_reg),__float_as_uint(l_reg),false,false);l_reg=__uint_as_float(rr[0])+__uint_as_float(rr[1]);}
  if(hi==0)wsf[32+r32]=l_reg;asm volatile("s_waitcnt lgkmcnt(0)":::"memory");
  float rli[16];
  #pragma unroll
  for(int r=0;r<16;++r)rli[r]=__builtin_amdgcn_rcpf(wsfh[32+(r&3)+8*(r>>2)]);
  bf16*Ow=O+(rowbase+q0+wid*QBLK)*DMO+h*D;
  { bf16*stg=(bf16*)(shm+LDS_OST)+wid*2048;
    bf16*stgh=stg+4*hi*64+r32;
    #pragma unroll
    for(int r=0;r<16;++r){
      #pragma unroll
      for(int d0=0;d0<2;++d0)stgh[((r&3)+8*(r>>2))*64+d0*32]=__float2bfloat16(o[d0][r]*rli[r]);}
    asm volatile("s_waitcnt lgkmcnt(0)":::"memory");
    #pragma unroll
    for(int i=0;i<4;++i){const int row=i*8+(lane>>3),ch=lane&7; const u32x4 v=*(const u32x4*)(stg+row*64+ch*8); ATTN_STORE16(Ow+(long)row*DMO+ch*8,v);} }
  asm volatile("s_waitcnt lgkmcnt(0)\n\ts_barrier":::"memory");
  #undef DMA_K
  #undef DMA_V
  #undef CMASK
  #undef KAUG
  #undef QAUG
  #undef START
  #undef RESC
  #undef ROT
}
constexpr int ATTN_LDS_BYTES=LDS_BYTES;
#undef SBAR
#undef WAIT_BAR
}

struct Frame {
    CParams* p; unsigned char* ws; LAS unsigned char* lds; int tid, lane, wid, G, bid;
    __device__ __forceinline__ Frame fresh() const { Frame G2 = *this; int t, w = wid; asm volatile("v_mbcnt_lo_u32_b32 %0, -1, 0\n\tv_mbcnt_hi_u32_b32 %0, -1, %0\n\tv_lshl_add_u32 %0, %1, 6, %0" : "=&v"(t), "+s"(w)); G2.tid = t; G2.lane = t & 63; G2.wid = w; return G2; }
    __device__ __forceinline__ bf16_t* hb() const { return (bf16_t*)(ws + WS_HB); }
    __device__ __forceinline__ bf16_t* x0() const { return (bf16_t*)p->out; }
    __device__ __forceinline__ bf16_t* ybuf() const { return (bf16_t*)p->out + (size_t)T * D; }
    __device__ __forceinline__ bf16_t* r1() const { return (bf16_t*)(ws + WS_R1); }
    __device__ __forceinline__ bf16_t* r2() const { return (bf16_t*)(ws + WS_R2); }
    __device__ __forceinline__ bf16_t* r3() const { return (bf16_t*)(ws + WS_R3); }
    __device__ __forceinline__ bf16_t* wt(size_t eoff) const { return (bf16_t*)(ws + WS_W) + eoff; }
    __device__ __forceinline__ float* smf(size_t boff) const { return (float*)(ws + WS_SM + boff); }
    __device__ __forceinline__ int* smi(size_t boff) const { return (int*)(ws + WS_SM + boff); }
};

struct CvtJob { const float* src; const float* src2; const float* gain; bf16_t* dst; int ld, mode, K, N, tile; };
constexpr int CV_A = 64 * 192, CV_B = 4 * 320, CV_C = 2 * 1680, CV_TOTAL = CV_A + CV_B + CV_C;
__device__ __forceinline__ void cvt_decode(const Frame& F, int g, CvtJob& J) {
    CParams& p = *F.p;
    J.src2 = nullptr; J.gain = nullptr; J.mode = 0;
    if (g < CV_A) { const int ie = g / 192, r = g % 192, i = ie >> 4;
        if (r < 128) { J.src = p.in[20] + (size_t)ie * D * DEXP; J.src2 = p.in[21] + (size_t)ie * D * DEXP; J.ld = DEXP; J.mode = 2; J.dst = F.wt(WL_UP + (size_t)ie * 512 * D); J.K = D; J.N = 512; J.gain = p.in[3] + i * D; J.tile = r; }
        else { J.src = p.in[22] + (size_t)ie * DEXP * D; J.ld = D; J.dst = F.wt(WL_DN + (size_t)ie * D * DEXP); J.K = DEXP; J.N = D; J.tile = r - 128; }
        return; }
    g -= CV_A;
    if (g < CV_B) { const int i = g / 320, r = g % 320;
        if (r < 64) { J.src = p.in[23] + (size_t)i * PLE * D; J.ld = D; J.dst = F.wt(WL_PP + (size_t)i * D * PLE); J.K = PLE; J.N = D; J.tile = r; }
        else { J.src = p.in[25] + (size_t)i * D * D; J.ld = D; J.dst = F.wt(WL_PG + (size_t)i * D * D); J.K = D; J.N = D; J.tile = r - 64; }
        return; }
    g -= CV_B;
    { const int j = g / 1680, r = g % 1680;
      if (r < 640) { J.src = p.in[4] + (size_t)j * D * EVEN_IN; J.ld = EVEN_IN; J.dst = F.wt(WE_IN + (size_t)j * EVEN_IN * D); J.K = D; J.N = EVEN_IN; J.gain = p.in[2] + (2 * j) * D; J.tile = r; }
      else if (r < 896) { J.src = p.in[8] + (size_t)j * D * D; J.ld = D; J.dst = F.wt(WE_OUT + (size_t)j * D * D); J.K = D; J.N = D; J.tile = r - 640; }
      else if (r < 1408) { J.src = p.in[9] + (size_t)j * D * ODD_IN; J.ld = ODD_IN; J.mode = 1; J.dst = F.wt(WO_IN + (size_t)j * ODD_N * D); J.K = D; J.N = ODD_N; J.gain = p.in[2] + (2 * j + 1) * D; J.tile = r - 896; }
      else if (r < 1664) { J.src = p.in[15] + (size_t)j * D * D; J.ld = D; J.dst = F.wt(WO_OUT + (size_t)j * D * D); J.K = D; J.N = D; J.tile = r - 1408; }
      else { const int gq = (r - 1664) >> 2; J.src = p.in[13] + ((size_t)j * 4 + gq) * 128 * 128; J.ld = 128; J.dst = F.wt(WO_POOL + ((size_t)j * 4 + gq) * 128 * 128); J.K = 128; J.N = 128; J.tile = (r - 1664) & 3; } }
}
__device__ __forceinline__ void p0_prologue(const Frame& F) {
    CParams& p = *F.p;
    { const float* x = p.in[0]; bf16_t* hb = F.x0(); float* ss = F.smf(SM_SSA);
      for (int row = F.bid * 8 + F.wid; row < T; row += F.G * 8) {
          float q = 0.f;
#pragma unroll
          for (int hf = 0; hf < 2; ++hf) { const size_t off = (size_t)row * D + hf * 512 + F.lane * 8;
              const f32x4 a = *(const f32x4*)(x + off), b = *(const f32x4*)(x + off + 4);
              u32x4 w; w.x = cvt_pk_bf16(a[0], a[1]); w.y = cvt_pk_bf16(a[2], a[3]); w.z = cvt_pk_bf16(b[0], b[1]); w.w = cvt_pk_bf16(b[2], b[3]);
              *(u32x4*)(hb + off) = w;
              q += (a[0] * a[0] + a[1] * a[1]) + (a[2] * a[2] + a[3] * a[3]) + (b[0] * b[0] + b[1] * b[1]) + (b[2] * b[2] + b[3] * b[3]); }
          q = wave_sum(q);
          if (F.lane < 16) ss[(size_t)row * 16 + F.lane] = F.lane == 0 ? q : 0.f; } }
    { LAS float* tile = (LAS float*)F.lds;
#pragma unroll 1
      for (int g = F.bid; g < CV_TOTAL; g += F.G) {
        CvtJob J; cvt_decode(F, g, J);
        const int tn = J.N >> 6; const int n0 = (J.tile % tn) * 64, k0 = (J.tile / tn) * 64;
        { const int kk = F.tid >> 3, nn = (F.tid & 7) * 8; const int n = n0 + nn; const float* sp = J.src; int col = n;
          if (J.mode == 1) col = n < 1536 ? n : n + 8;
          if (J.mode == 2) { const int pn = n >> 8, half = (n >> 7) & 1, c = n & 127; sp = half ? J.src2 : J.src; col = pn * 128 + c; }
          const float gn = J.gain ? J.gain[k0 + kk] : 1.0f;
          const f32x4 a = *(const f32x4*)(sp + (size_t)(k0 + kk) * J.ld + col), b = *(const f32x4*)(sp + (size_t)(k0 + kk) * J.ld + col + 4);
#pragma unroll
          for (int q = 0; q < 4; ++q) { tile[kk * 65 + nn + q] = a[q] * gn; tile[kk * 65 + nn + 4 + q] = b[q] * gn; } }
        __syncthreads();
        { const int nn = F.tid >> 3, kc = (F.tid & 7) * 8; float v[8];
#pragma unroll
          for (int q = 0; q < 8; ++q) v[q] = tile[(kc + q) * 65 + nn];
          u32x4 w; w.x = cvt_pk_bf16(v[0], v[1]); w.y = cvt_pk_bf16(v[2], v[3]); w.z = cvt_pk_bf16(v[4], v[5]); w.w = cvt_pk_bf16(v[6], v[7]);
          *(u32x4*)(J.dst + (size_t)(n0 + nn) * J.K + k0 + kc) = w; }
        __syncthreads();
      } }
    { const float* s = p.in[5]; bf16_t* d = F.wt(WE_SGU);
      for (int i = F.bid * NTHREADS + F.tid; i < 2 * 8 * 128 * 128 / 8; i += F.G * NTHREADS) {
          const int e0 = i * 8, tt = (e0 >> 7) & 127, s0 = e0 & 127; float v[8];
          const f32x4 a = *(const f32x4*)(s + e0), b = *(const f32x4*)(s + e0 + 4);
#pragma unroll
          for (int j = 0; j < 4; ++j) { v[j] = (s0 + j <= tt) ? a[j] : 0.f; v[4 + j] = (s0 + 4 + j <= tt) ? b[j] : 0.f; }
          u32x4 w; w.x = cvt_pk_bf16(v[0], v[1]); w.y = cvt_pk_bf16(v[2], v[3]); w.z = cvt_pk_bf16(v[4], v[5]); w.w = cvt_pk_bf16(v[6], v[7]);
          *(u32x4*)(d + e0) = w; } }
    for (int i = F.bid * NTHREADS + F.tid; i < 2 * 16 * D; i += F.G * NTHREADS) {
        const int j = i / (16 * D), h = (i / D) & 15, k = i % D;
        const float w = h < 8 ? p.in[2][(2 * j + 1) * D + k] * p.in[9][((size_t)j * D + k) * ODD_IN + 1536 + h] : 0.f;
        const unsigned hi = cvt_pk_bf16(w, 0.f) & 0xffffu; const unsigned lo = cvt_pk_bf16(w - bf_lo(hi), 0.f) & 0xffffu;
        bf16_t* wb = (bf16_t*)(F.ws + WS_SM + SM_WFB) + (size_t)j * 2 * 16 * D;
        wb[h * D + k] = (bf16_t)hi; wb[16 * D + h * D + k] = (bf16_t)lo; }
    for (int i = F.bid * NTHREADS + F.tid; i < 4 * 32 * D; i += F.G * NTHREADS) {
        const int l = i / (32 * D), o = (i / D) & 31, k = i % D;
        float w = 0.f;
        if (o < 4) w = p.in[16][((size_t)l * D + k) * 4 + o]; else if (o < 20) w = p.in[18][((size_t)l * D + k) * 16 + (o - 4)];
        w *= p.in[3][l * D + k];
        const unsigned hi = cvt_pk_bf16(w, 0.f) & 0xffffu; const unsigned lo = cvt_pk_bf16(w - bf_lo(hi), 0.f) & 0xffffu;
        bf16_t* rb = (bf16_t*)(F.ws + WS_SM + SM_RWB) + (size_t)l * 2 * 32 * D;
        rb[o * D + k] = (bf16_t)hi; rb[32 * D + o * D + k] = (bf16_t)lo; }
}

__device__ __forceinline__ void logf_units(const Frame& F, int j) {
    CParams& p = *F.p;
    constexpr int WP = 1032;
    LAS unsigned char* wls = F.lds;
    const bf16_t* wfb = (const bf16_t*)(F.ws + WS_SM + SM_WFB) + (size_t)j * 2 * 16 * D;
    __syncthreads();
    for (int i = F.tid; i < 2 * 8 * 128; i += NTHREADS) { const int hl = i / (8 * 128), o = (i / 128) & 7, c = i & 127;
        *(LAS u32x4*)(wls + ((hl * 8 + o) * WP + c * 8) * 2) = *(const u32x4*)(wfb + (size_t)hl * 16 * D + (size_t)o * D + c * 8); }
    __syncthreads();
    const bf16_t* hb = F.x0(); const float* ss = F.smf(SM_SSA); float* lf = F.smf(SM_LOGF);
    const int l15 = F.lane & 15, lq = F.lane >> 4;
    const bool zr = l15 >= 8; const int o = zr ? 0 : l15;
    const LAS unsigned char* wh = wls + (o * WP + 8 * lq) * 2; const LAS unsigned char* wl = wh + 8 * WP * 2;
    for (int blk = F.bid; blk < T / 128; blk += F.G) {
        const int row0 = blk * 128 + F.wid * 16;
        const bf16_t* xp = hb + (size_t)(row0 + l15) * D + 8 * lq;
        f32x4 acc = (f32x4){0.f, 0.f, 0.f, 0.f};
#pragma unroll 8
        for (int ks = 0; ks < 32; ++ks) {
            const bf16x8 ah = *(const bf16x8*)(xp + ks * 32);
            bf16x8 bh = *(const LAS bf16x8*)(wh + ks * 64), bl = *(const LAS bf16x8*)(wl + ks * 64);
            if (zr) { bh = (bf16x8){0, 0, 0, 0, 0, 0, 0, 0}; bl = bh; }
            acc = __builtin_amdgcn_mfma_f32_16x16x32_bf16(ah, bh, acc, 0, 0, 0); acc = __builtin_amdgcn_mfma_f32_16x16x32_bf16(ah, bl, acc, 0, 0, 0); }
        if (l15 < 8) {
            const float fb = p.in[10][j * 8 + l15];
#pragma unroll
            for (int e = 0; e < 4; ++e) { const int row = row0 + 4 * lq + e;
                const float xx = acc[e] * rstd_from16(ss + (size_t)row * 16) + fb;
                lf[((size_t)(row >> 12) * 8 + l15) * SEQ + (row & (SEQ - 1))] = fminf(xx, 0.f) - 0.6931471806f * __builtin_amdgcn_logf(1.0f + fast_exp2(-LOG2E * fabsf(xx))); } }
    }
    __syncthreads();
}

constexpr int AT_KP = 72;

__device__ __forceinline__ void sb_wave_unit(const Frame& F, const bf16_t* Q, const bf16_t* Kg, const bf16_t* Vg, int ld, bf16_t* O, int ldo, int b, int h, int qblk) {
    const int lane = F.lane, r32 = lane & 31, hh = lane >> 5;
    LAS unsigned char* vl = F.lds + F.wid * (64 * AT_KP * 2);
    const int trb = ((((lane & 15) >> 2) + 4 * hh) * AT_KP + ((lane >> 4) & 1) * 16 + (lane & 3) * 4) * 2;
    const int qw0 = qblk * 32; const size_t rowbase = (size_t)b * SEQ;
    bf16x8 qf[4];
#pragma unroll
    for (int s = 0; s < 4; ++s) qf[s] = *(const bf16x8*)(Q + (rowbase + qw0 + r32) * ld + h * 64 + s * 16 + hh * 8);
    f32x16 o0, o1;
#pragma unroll
    for (int i = 0; i < 16; ++i) { o0[i] = 0.f; o1[i] = 0.f; }
    float R = 1.0f;
    const int kt0 = (qw0 + 30) >> 6;
    const bf16_t* kbase = Kg + rowbase * ld + h * 64 + hh * 8;
    const bf16_t* vbase = Vg + rowbase * ld + h * 64 + (lane & 7) * 8;
    bf16x8 kf[2][4]; u32x4 vr[8];
#pragma unroll
    for (int kb = 0; kb < 2; ++kb)
#pragma unroll
        for (int s = 0; s < 4; ++s) kf[kb][s] = *(const bf16x8*)(kbase + (size_t)(kt0 * 64 + kb * 32 + r32) * ld + s * 16);
#pragma unroll
    for (int i = 0; i < 8; ++i) vr[i] = *(const u32x4*)(vbase + (size_t)(kt0 * 64 + i * 8 + (lane >> 3)) * ld);
#pragma unroll 1
    for (int kt = kt0; kt >= 0; --kt) {
#pragma unroll
        for (int i = 0; i < 8; ++i) *(LAS u32x4*)(vl + ((i * 8 + (lane >> 3)) * AT_KP + (lane & 7) * 8) * 2) = vr[i];
        f32x16 s0, s1;
#pragma unroll
        for (int i = 0; i < 16; ++i) { s0[i] = 0.f; s1[i] = 0.f; }
#pragma unroll
        for (int s = 0; s < 4; ++s) { s0 = MFMA32(kf[0][s], qf[s], s0); s1 = MFMA32(kf[1][s], qf[s], s1); }
        if (kt > 0) {
#pragma unroll
            for (int kb = 0; kb < 2; ++kb)
#pragma unroll
                for (int s = 0; s < 4; ++s) kf[kb][s] = *(const bf16x8*)(kbase + (size_t)((kt - 1) * 64 + kb * 32 + r32) * ld + s * 16);
#pragma unroll
            for (int i = 0; i < 8; ++i) vr[i] = *(const u32x4*)(vbase + (size_t)((kt - 1) * 64 + i * 8 + (lane >> 3)) * ld); }
        const int lim = (qw0 + r32) - (kt * 64 + 4 * hh);
        const bool diag = kt * 64 + 63 >= qw0;
        float gp0[4], gp1[4];
#pragma unroll
        for (int a = 0; a < 4; ++a) {
            float be0[4], om0[4], be1[4], om1[4];
#pragma unroll
            for (int e = 0; e < 4; ++e) {
                { const float ex = fast_exp2(-fmaxf(s0[4 * a + e], -126.f)), r = fast_rcp(1.0f + ex);
                  const bool msk = diag && (8 * a + e) >= lim; be0[e] = msk ? 0.f : r; om0[e] = msk ? 1.f : ex * r; }
                { const float ex = fast_exp2(-fmaxf(s1[4 * a + e], -126.f)), r = fast_rcp(1.0f + ex);
                  const bool msk = diag && (8 * a + e + 32) >= lim; be1[e] = msk ? 0.f : r; om1[e] = msk ? 1.f : ex * r; } }
            { const float c2 = om0[3], c1 = c2 * om0[2], c0 = c1 * om0[1]; gp0[a] = c0 * om0[0];
              s0[4 * a + 3] = be0[3]; s0[4 * a + 2] = be0[2] * c2; s0[4 * a + 1] = be0[1] * c1; s0[4 * a] = be0[0] * c0; }
            { const float c2 = om1[3], c1 = c2 * om1[2], c0 = c1 * om1[1]; gp1[a] = c0 * om1[0];
              s1[4 * a + 3] = be1[3]; s1[4 * a + 2] = be1[2] * c2; s1[4 * a + 1] = be1[1] * c1; s1[4 * a] = be1[0] * c0; } }
        float pp0[4], pp1[4];
#pragma unroll
        for (int a = 0; a < 4; ++a) { pp0[a] = other_x32(gp0[a], hh); pp1[a] = other_x32(gp1[a], hh); }
        float S0[4], S1[4]; float t0 = 1.0f, t1 = 1.0f;
#pragma unroll
        for (int a = 3; a >= 0; --a) { S0[a] = t0 * (hh == 0 ? pp0[a] : 1.0f); S1[a] = t1 * (hh == 0 ? pp1[a] : 1.0f); t0 *= gp0[a] * pp0[a]; t1 *= gp1[a] * pp1[a]; }
        const float R1 = R, R0 = R * t1;
#pragma unroll
        for (int a = 0; a < 4; ++a)
#pragma unroll
            for (int e = 0; e < 4; ++e) { s1[4 * a + e] *= R1 * S1[a]; s0[4 * a + e] *= R0 * S0[a]; }
        R = R0 * t0;
#pragma unroll
        for (int kb = 0; kb < 2; ++kb)
#pragma unroll
            for (int j = 0; j < 2; ++j) {
                const f32x16& sv = kb ? s1 : s0;
                u32x4 pw; pw.x = cvt_pk_bf16(sv[8 * j], sv[8 * j + 1]); pw.y = cvt_pk_bf16(sv[8 * j + 2], sv[8 * j + 3]); pw.z = cvt_pk_bf16(sv[8 * j + 4], sv[8 * j + 5]); pw.w = cvt_pk_bf16(sv[8 * j + 6], sv[8 * j + 7]);
                const bf16x8 pb = __builtin_bit_cast(bf16x8, pw);
                const int kb16 = ((32 * kb + 16 * j) * AT_KP) * 2;
                { const s16x4 lo = tr_read(vl + kb16 + trb), hi = tr_read(vl + kb16 + trb + 8 * AT_KP * 2);
                  o0 = MFMA32(((bf16x8){lo[0], lo[1], lo[2], lo[3], hi[0], hi[1], hi[2], hi[3]}), pb, o0); }
                { const s16x4 lo = tr_read(vl + kb16 + trb + 64), hi = tr_read(vl + kb16 + trb + 8 * AT_KP * 2 + 64);
                  o1 = MFMA32(((bf16x8){lo[0], lo[1], lo[2], lo[3], hi[0], hi[1], hi[2], hi[3]}), pb, o1); }
            }
        if (__all(R < 1e-37f)) break;
    }
    bf16_t* orow = O + (rowbase + qw0 + r32) * ldo + h * 64;
#pragma unroll
    for (int a = 0; a < 4; ++a) {
        u32x2 w0, w1;
        w0.x = cvt_pk_bf16(o0[4 * a], o0[4 * a + 1]); w0.y = cvt_pk_bf16(o0[4 * a + 2], o0[4 * a + 3]);
        w1.x = cvt_pk_bf16(o1[4 * a], o1[4 * a + 1]); w1.y = cvt_pk_bf16(o1[4 * a + 2], o1[4 * a + 3]);
        *(u32x2*)(orow + 8 * a + 4 * hh) = w0; *(u32x2*)(orow + 32 + 8 * a + 4 * hh) = w1; }
}

constexpr int SG_P = 136;
__device__ __forceinline__ void sgu_unit(const Frame& F, int j, int unit) {
    CParams& p = *F.p;
    const bf16_t* proj = F.r1(); bf16_t* y = F.ybuf();
    const int r0 = unit * 128, lane = F.lane, r32 = lane & 31, hh = lane >> 5, tb = F.wid & 3, db = F.wid >> 2;
    LAS unsigned char* vl = F.lds;
    const int ls = F.tid >> 2, ld0 = (F.tid & 3) * 16;
    const int trb = ((((lane & 15) >> 2) + 8 * hh) * AT_KP + 32 * db + ((lane >> 4) & 1) * 16 + (lane & 3) * 4) * 2;
    const bf16_t* vsrc = proj + (size_t)(r0 + ls) * EVEN_IN + 512 + ld0;
    u32x4 va = *(const u32x4*)vsrc, vb = *(const u32x4*)(vsrc + 8);
    const int t = 32 * tb + r32, nks = 2 * tb + 2;
    for (int h = 0; h < 8; ++h) {
        __syncthreads();
        *(LAS u32x4*)(vl + (ls * AT_KP + ld0) * 2) = va; *(LAS u32x4*)(vl + (ls * AT_KP + ld0 + 8) * 2) = vb;
        __syncthreads();
        if (h < 7) { va = *(const u32x4*)(vsrc + (h + 1) * 64); vb = *(const u32x4*)(vsrc + (h + 1) * 64 + 8); }
        const bf16_t* W = F.wt(WE_SGU) + ((size_t)j * 8 + h) * 128 * 128;
        bf16x8 bfr[8];
#pragma unroll
        for (int ks = 0; ks < 8; ++ks) if (ks < nks) bfr[ks] = *(const bf16x8*)(W + (size_t)t * 128 + ks * 16 + hh * 8);
        u32x2 uw[4];
#pragma unroll
        for (int a = 0; a < 4; ++a) uw[a] = *(const u32x2*)(proj + (size_t)(r0 + t) * EVEN_IN + h * 64 + 32 * db + 8 * a + 4 * hh);
        const float bs = p.in[6][((size_t)j * 8 + h) * 128 + t];
        f32x16 acc;
#pragma unroll
        for (int i = 0; i < 16; ++i) acc[i] = 0.f;
#pragma unroll
        for (int ks = 0; ks < 8; ++ks) if (ks < nks) {
            const s16x4 lo = tr_read(vl + ks * 16 * AT_KP * 2 + trb), hi = tr_read(vl + ks * 16 * AT_KP * 2 + trb + 4 * AT_KP * 2);
            acc = MFMA32(((bf16x8){lo[0], lo[1], lo[2], lo[3], hi[0], hi[1], hi[2], hi[3]}), bfr[ks], acc); }
#pragma unroll
        for (int a = 0; a < 4; ++a) {
            const int d0 = 32 * db + 8 * a + 4 * hh;
            u32x2 w; w.x = cvt_pk_bf16(bf_lo(uw[a].x) * (acc[4 * a] + bs), bf_hi(uw[a].x) * (acc[4 * a + 1] + bs)); w.y = cvt_pk_bf16(bf_lo(uw[a].y) * (acc[4 * a + 2] + bs), bf_hi(uw[a].y) * (acc[4 * a + 3] + bs));
            *(u32x2*)(y + (size_t)(r0 + t) * D + h * 64 + d0) = w; }
    }
}

template <int WIN>
__device__ __forceinline__ void pool_strip(const bf16_t* col, int r0, int pos0, int t0, LAS unsigned char* dst) {
    u32x4 rw[WIN + 3];
#pragma unroll
    for (int i = 0; i < WIN + 3; ++i) { const int r = t0 - (WIN - 1) + i; const int rr = pos0 + r >= 0 ? r : t0;
        rw[i] = *(const u32x4*)(col + (size_t)(r0 + rr) * ODD_N); }
    float sum[8];
#pragma unroll
    for (int q = 0; q < 8; ++q) sum[q] = 0.f;
#pragma unroll
    for (int i = 0; i < WIN - 1; ++i) { const float mk = pos0 + t0 - (WIN - 1) + i >= 0 ? 1.0f : 0.0f; const u32x4 w = rw[i];
        sum[0] += mk * bf_lo(w.x); sum[1] += mk * bf_hi(w.x); sum[2] += mk * bf_lo(w.y); sum[3] += mk * bf_hi(w.y); sum[4] += mk * bf_lo(w.z); sum[5] += mk * bf_hi(w.z); sum[6] += mk * bf_lo(w.w); sum[7] += mk * bf_hi(w.w); }
#pragma unroll
    for (int dt = 0; dt < 4; ++dt) {
        const int pos = pos0 + t0 + dt; const u32x4 w = rw[WIN - 1 + dt];
        const float xv[8] = {bf_lo(w.x), bf_hi(w.x), bf_lo(w.y), bf_hi(w.y), bf_lo(w.z), bf_hi(w.z), bf_lo(w.w), bf_hi(w.w)};
#pragma unroll
        for (int q = 0; q < 8; ++q) sum[q] += xv[q];
        const int cnt = pos + 1 < WIN ? pos + 1 : WIN; const float ic = 1.0f / (float)cnt;
        u32x4 o; o.x = cvt_pk_bf16(sum[0] * ic - xv[0], sum[1] * ic - xv[1]); o.y = cvt_pk_bf16(sum[2] * ic - xv[2], sum[3] * ic - xv[3]);
        o.z = cvt_pk_bf16(sum[4] * ic - xv[4], sum[5] * ic - xv[5]); o.w = cvt_pk_bf16(sum[6] * ic - xv[6], sum[7] * ic - xv[7]);
        *(LAS u32x4*)(dst + (t0 + dt) * SG_P * 2) = o;
        { const float mk = pos - (WIN - 1) >= 0 ? 1.0f : 0.0f; const u32x4 wo = rw[dt];
          sum[0] -= mk * bf_lo(wo.x); sum[1] -= mk * bf_hi(wo.x); sum[2] -= mk * bf_lo(wo.y); sum[3] -= mk * bf_hi(wo.y); sum[4] -= mk * bf_lo(wo.z); sum[5] -= mk * bf_hi(wo.z); sum[6] -= mk * bf_lo(wo.w); sum[7] -= mk * bf_hi(wo.w); } }
}

__device__ __forceinline__ void pool_unit(const Frame& F, int j, int unit) {
    CParams& p = *F.p;
    const bf16_t* proj = F.r1(); bf16_t* y = F.ybuf();
    const int r0 = unit * 128, pos0 = r0 & (SEQ - 1), lane = F.lane, r32 = lane & 31, hh = lane >> 5, tb = F.wid & 3, dbp = F.wid >> 2;
    LAS bf16_t* pl = (LAS bf16_t*)F.lds;
    for (int g = 0; g < 4; ++g) {
        const int win = 2 << g;
        __syncthreads();
        { const int t0 = (F.tid >> 4) * 4, c8 = (F.tid & 15) * 8;
          const bf16_t* col = proj + 1536 + g * 128 + c8;
          if (g == 0) pool_strip<2>(col, r0, pos0, t0, (LAS unsigned char*)pl + c8 * 2);
          else if (g == 1) pool_strip<4>(col, r0, pos0, t0, (LAS unsigned char*)pl + c8 * 2);
          else if (g == 2) pool_strip<8>(col, r0, pos0, t0, (LAS unsigned char*)pl + c8 * 2);
          else pool_strip<16>(col, r0, pos0, t0, (LAS unsigned char*)pl + c8 * 2); }
        __syncthreads();
        const bf16_t* W = F.wt(WO_POOL) + ((size_t)j * 4 + g) * 128 * 128;
#pragma unroll
        for (int dd = 0; dd < 2; ++dd) {
            const int db = dbp * 2 + dd;
            f32x16 acc;
#pragma unroll
            for (int i = 0; i < 16; ++i) acc[i] = 0.f;
#pragma unroll
            for (int ks = 0; ks < 8; ++ks) {
                const bf16x8 af = *(const bf16x8*)(W + (size_t)(32 * db + r32) * 128 + ks * 16 + hh * 8);
                const bf16x8 bf = *(const LAS bf16x8*)((LAS unsigned char*)pl + ((32 * tb + r32) * SG_P + ks * 16 + hh * 8) * 2);
                acc = MFMA32(af, bf, acc); }
            const int t = 32 * tb + r32;
#pragma unroll
            for (int a = 0; a < 4; ++a) {
                const int d0 = 32 * db + 8 * a + 4 * hh;
                const f32x4 sc = *(const f32x4*)(p.in[14] + (size_t)j * 512 + g * 128 + d0);
                u32x2 w; w.x = cvt_pk_bf16(acc[4 * a] * sc[0], acc[4 * a + 1] * sc[1]); w.y = cvt_pk_bf16(acc[4 * a + 2] * sc[2], acc[4 * a + 3] * sc[3]);
                *(u32x2*)(y + (size_t)(r0 + t) * D + 512 + g * 128 + d0) = w; }
        }
    }
}

__device__ __forceinline__ void router_phase(const Frame& F, int layer) {
    CParams& p = *F.p;
    constexpr int RWP = 1032;
    LAS bf16_t* wls = (LAS bf16_t*)F.lds;
    LAS float* lgs = (LAS float*)(F.lds + 86016) + F.wid * (16 * 33);
    LAS int* se = (LAS int*)(F.lds + 104448);
    const bf16_t* rwh = (const bf16_t*)(F.ws + WS_SM + SM_RWB) + (size_t)layer * 2 * 32 * D;
    __syncthreads();
    for (int i = F.tid; i < 2 * 20 * 128; i += NTHREADS) { const int hl = i / (20 * 128), o = (i / 128) % 20, c = i & 127;
        *(LAS u32x4*)((LAS unsigned char*)wls + ((hl * 20 + o) * RWP + c * 8) * 2) = *(const u32x4*)(rwh + (size_t)hl * 32 * D + (size_t)o * D + c * 8); }
    __syncthreads();
    const float* ssB = F.smf(SM_SSB);
    float* rstd1 = F.smf(SM_RSTD1); int* tokrec = F.smi(SM_TOKREC);
    const int l15 = F.lane & 15, lq = F.lane >> 4;
    for (int blk = F.bid; blk < T / 128; blk += F.G) {
        const int row0 = blk * 128 + F.wid * 16;
        const bf16_t* xp = F.hb() + (size_t)(row0 + l15) * D + 8 * lq;
        const LAS unsigned char* wh0 = (const LAS unsigned char*)wls + (l15 * RWP + 8 * lq) * 2; const LAS unsigned char* wl0 = wh0 + 20 * RWP * 2;
        const int o1 = l15 < 4 ? 16 + l15 : 0; const bool z1 = l15 >= 4;
        const LAS unsigned char* wh1 = (const LAS unsigned char*)wls + (o1 * RWP + 8 * lq) * 2; const LAS unsigned char* wl1 = wh1 + 20 * RWP * 2;
        f32x4 acc0 = (f32x4){0.f, 0.f, 0.f, 0.f}, acc1 = (f32x4){0.f, 0.f, 0.f, 0.f};
#pragma unroll 8
        for (int ks = 0; ks < 32; ++ks) {
            const bf16x8 ah = *(const bf16x8*)(xp + ks * 32);
            const bf16x8 bh0 = *(const LAS bf16x8*)(wh0 + ks * 64), bl0 = *(const LAS bf16x8*)(wl0 + ks * 64);
            bf16x8 bh1 = *(const LAS bf16x8*)(wh1 + ks * 64), bl1 = *(const LAS bf16x8*)(wl1 + ks * 64);
            if (z1) { bh1 = (bf16x8){0, 0, 0, 0, 0, 0, 0, 0}; bl1 = bh1; }
            acc0 = __builtin_amdgcn_mfma_f32_16x16x32_bf16(ah, bh0, acc0, 0, 0, 0); acc0 = __builtin_amdgcn_mfma_f32_16x16x32_bf16(ah, bl0, acc0, 0, 0, 0);
            acc1 = __builtin_amdgcn_mfma_f32_16x16x32_bf16(ah, bh1, acc1, 0, 0, 0); acc1 = __builtin_amdgcn_mfma_f32_16x16x32_bf16(ah, bl1, acc1, 0, 0, 0);
        }
#pragma unroll
        for (int e = 0; e < 4; ++e) { lgs[(4 * lq + e) * 33 + l15] = acc0[e]; lgs[(4 * lq + e) * 33 + 16 + l15] = acc1[e]; }
        __syncthreads();
        if (F.lane < 16) {
            const int row = row0 + F.lane;
            const float rs = rstd_from16(ssB + (size_t)row * 16);
            float lg[4], le[16];
#pragma unroll
            for (int o = 0; o < 4; ++o) lg[o] = lgs[F.lane * 33 + o] * rs + p.in[17][layer * 4 + o];
#pragma unroll
            for (int o = 0; o < 16; ++o) le[o] = lgs[F.lane * 33 + 4 + o] * rs + p.in[19][layer * 16 + o];
            int gi = 0; float gm = lg[0]; float v[4] = {le[0], le[1], le[2], le[3]};
#pragma unroll
            for (int o = 1; o < 4; ++o) { const bool better = lg[o] > gm; gm = better ? lg[o] : gm; gi = better ? o : gi;
                v[0] = better ? le[4 * o] : v[0]; v[1] = better ? le[4 * o + 1] : v[1]; v[2] = better ? le[4 * o + 2] : v[2]; v[3] = better ? le[4 * o + 3] : v[3]; }
            float den = 0.f;
#pragma unroll
            for (int o = 0; o < 4; ++o) den += expf(lg[o] - gm);
            const float gpv = 1.0f / den;
            int i0 = 0; float m0 = v[0];
#pragma unroll
            for (int o = 1; o < 4; ++o) if (v[o] > m0) { m0 = v[o]; i0 = o; }
            int i1 = -1; float m1 = -INFINITY;
#pragma unroll
            for (int o = 0; o < 4; ++o) if (o != i0 && v[o] > m1) { m1 = v[o]; i1 = o; }
            const float w0 = gpv / (1.0f + expf(m1 - m0)), w1 = gpv - w0;
            rstd1[row] = rs;
            int* tr = tokrec + (size_t)row * 4; tr[0] = gi * 4 + i0; tr[1] = gi * 4 + i1; tr[2] = __float_as_int(w0); tr[3] = __float_as_int(w1);
            se[(F.wid * 16 + F.lane) * 2] = gi * 4 + i0; se[(F.wid * 16 + F.lane) * 2 + 1] = gi * 4 + i1;
        }
        __syncthreads();
#pragma unroll
        for (int q = 0; q < 2; ++q) {
            const int e = F.wid * 2 + q; int n = 0; int* lst = F.smi(SM_LISTS) + ((size_t)blk * 16 + e) * 128;
#pragma unroll
            for (int r = 0; r < 2; ++r) {
                const int t = r * 64 + F.lane; const bool a0 = se[2 * t] == e, a1 = se[2 * t + 1] == e; const bool m = a0 || a1;
                const unsigned long long mask = __builtin_amdgcn_ballot_w64(m);
                const int pos = n + (int)__builtin_amdgcn_mbcnt_hi((unsigned)(mask >> 32), __builtin_amdgcn_mbcnt_lo((unsigned)mask, 0u));
                if (m) lst[pos] = (blk * 128 + t) * 2 + (a1 ? 1 : 0);
                n += __builtin_popcountll(mask); }
            if (F.lane == 0) F.smi(SM_COUNTS)[blk * 16 + e] = n; }
        __syncthreads();
    }
    { const float* ps = p.in[1] + (size_t)layer * T * PLE; bf16_t* pb = F.ybuf();
      for (size_t i = (size_t)F.bid * NTHREADS + F.tid; i < (size_t)T * PLE / 8; i += (size_t)F.G * NTHREADS) {
          const f32x4 a = *(const f32x4*)(ps + i * 8), b = *(const f32x4*)(ps + i * 8 + 4);
          u32x4 w; w.x = cvt_pk_bf16(a[0], a[1]); w.y = cvt_pk_bf16(a[2], a[3]); w.z = cvt_pk_bf16(b[0], b[1]); w.w = cvt_pk_bf16(b[2], b[3]);
          *(u32x4*)(pb + i * 8) = w; } }
}

__device__ __forceinline__ void scatter_phase(const Frame& F) {
    LAS int* cn = (LAS int*)F.lds;
    LAS int* part = (LAS int*)(F.lds + 16384);
    LAS int* tot = (LAS int*)(F.lds + 16384 + 2048);
    LAS int* pre = tot + 16; LAS int* base = tot + 32;
    const int* counts = F.smi(SM_COUNTS);
    __syncthreads();
    for (int i = F.tid; i < 4096; i += NTHREADS) cn[i] = counts[i];
    __syncthreads();
    { const int e = F.tid & 15, ch = F.tid >> 4; int s = 0;
#pragma unroll
      for (int q = 0; q < 8; ++q) s += cn[(ch * 8 + q) * 16 + e];
      part[ch * 16 + e] = s; }
    __syncthreads();
    for (int blk = F.bid; blk < 256; blk += F.G) {
        __syncthreads();
        if (F.tid < 16) { int tt = 0, pp = 0; const int bch = blk >> 3;
            for (int ch = 0; ch < 32; ++ch) { const int v = part[ch * 16 + F.tid]; tt += v; pp += ch < bch ? v : 0; }
            for (int q = bch * 8; q < blk; ++q) pp += cn[q * 16 + F.tid];
            tot[F.tid] = tt; pre[F.tid] = pp; }
        __syncthreads();
        if (F.tid == 0) { int bsum = 0; for (int e = 0; e < 16; ++e) { base[e] = bsum; bsum += (tot[e] + 255) & ~255; } base[16] = bsum;
            if (blk == 0) { int* eb = F.smi(SM_EBASE); for (int e = 0; e <= 16; ++e) eb[e] = base[e]; } }
        __syncthreads();
        int* rowtok = F.smi(SM_ROWTOK); float* roww = F.smf(SM_ROWW); float* rowrs = F.smf(SM_ROWRS);
        const int* tokrec = F.smi(SM_TOKREC); const float* rstd1 = F.smf(SM_RSTD1);
        if (F.tid < 256) {
            int e = 0, idx = F.tid;
            for (int q = 0; q < 16; ++q) { const int c = cn[blk * 16 + q]; if (e == q && idx >= c) { idx -= c; e = q + 1; } }
            if (e < 16) {
                const int item = F.smi(SM_LISTS)[((size_t)blk * 16 + e) * 128 + idx];
                const int pos = base[e] + pre[e] + idx, tok = item >> 1;
                rowtok[pos] = item; roww[pos] = __int_as_float(tokrec[(size_t)tok * 4 + 2 + (item & 1)]); rowrs[pos] = rstd1[tok]; } }
        if (blk < 16) { const int e = blk; for (int q = base[e] + tot[e] + F.tid; q < base[e + 1]; q += NTHREADS) rowtok[q] = -1; }
    }
    __syncthreads();
}

__device__ __forceinline__ void combine_phase(const Frame& F) {
    bf16_t* hb = F.hb(); const bf16_t* Y = F.r1(); float* rstd2 = F.smf(SM_RSTD2);
    for (int row = F.bid * 8 + F.wid; row < T; row += F.G * 8) {
        float q = 0.f;
#pragma unroll
        for (int hf = 0; hf < 2; ++hf) { const size_t off = (size_t)row * D + hf * 512 + F.lane * 8;
            const u32x4 hw = *(const u32x4*)(hb + off), y0 = *(const u32x4*)(Y + off), y1 = *(const u32x4*)(Y + (size_t)T * D + off);
            f32x4 a, b;
            a[0] = bf_lo(hw.x) + (bf_lo(y0.x) + bf_lo(y1.x)); a[1] = bf_hi(hw.x) + (bf_hi(y0.x) + bf_hi(y1.x)); a[2] = bf_lo(hw.y) + (bf_lo(y0.y) + bf_lo(y1.y)); a[3] = bf_hi(hw.y) + (bf_hi(y0.y) + bf_hi(y1.y));
            b[0] = bf_lo(hw.z) + (bf_lo(y0.z) + bf_lo(y1.z)); b[1] = bf_hi(hw.z) + (bf_hi(y0.z) + bf_hi(y1.z)); b[2] = bf_lo(hw.w) + (bf_lo(y0.w) + bf_lo(y1.w)); b[3] = bf_hi(hw.w) + (bf_hi(y0.w) + bf_hi(y1.w));
            u32x4 w; w.x = cvt_pk_bf16(a[0], a[1]); w.y = cvt_pk_bf16(a[2], a[3]); w.z = cvt_pk_bf16(b[0], b[1]); w.w = cvt_pk_bf16(b[2], b[3]);
            *(u32x4*)(hb + off) = w;
            q += (a[0] * a[0] + a[1] * a[1]) + (a[2] * a[2] + a[3] * a[3]) + (b[0] * b[0] + b[1] * b[1]) + (b[2] * b[2] + b[3] * b[3]); }
        q = wave_sum(q);
        if (F.lane == 0) { rstd2[row] = 1.0f / sqrtf(q * (1.0f / 1024.0f) + EPS); F.smf(SM_RSTDE)[row] = rstd_from16(F.smf(SM_SSE) + (size_t)row * 16); }
    }
}

constexpr int FOX_KB = 86016, FOX_SCAN = FOX_KB + 32768;
static_assert(attn_body::ATTN_LDS_BYTES <= FOX_KB && FOX_SCAN + 128 <= RING_BYTES, "attention LDS map");
__device__ __forceinline__ void fox_kbias(const Frame& F, int b, int h, const float* logf, const float* gqn, const float* gkn) {
    LAS u32x2* krec = (LAS u32x2*)(F.lds + FOX_KB); LAS float* wsum = (LAS float*)(F.lds + FOX_SCAN);
    __syncthreads();
    float v[8]; float run = 0.f;
    { const float* lp = logf + ((size_t)b * 8 + h) * SEQ + F.tid * 8; const f32x4 l0 = *(const f32x4*)lp, l1 = *(const f32x4*)(lp + 4);
      const float lv[8] = {l0[0], l0[1], l0[2], l0[3], l1[0], l1[1], l1[2], l1[3]};
#pragma unroll
      for (int j = 0; j < 8; ++j) { run += lv[j]; v[j] = run; } }
    float inc = run;
#pragma unroll
    for (int o = 1; o < 64; o <<= 1) { const float t = __int_as_float(__builtin_amdgcn_ds_bpermute((F.lane - o) << 2, __float_as_int(inc))); if (F.lane >= o) inc += t; }
    if (F.lane == 63) wsum[F.wid] = inc;
    __syncthreads();
    float base = inc - run;
    for (int w = 0; w < F.wid; ++w) base += wsum[w];
#pragma unroll
    for (int j = 0; j < 8; ++j) { const float kb = -LOG2E * (base + v[j]);
        const unsigned ph = cvt_pk_bf16(kb, 0.f) & 0xffffu; const float r1 = kb - bf_lo(ph); const unsigned pm = cvt_pk_bf16(r1, 0.f) & 0xffffu; const float r2 = r1 - bf_lo(pm); const unsigned pl = cvt_pk_bf16(r2, 0.f) & 0xffffu;
        u32x2 rc; rc.x = ph | (pm << 16); rc.y = pl; krec[F.tid * 8 + j] = rc; }
    if (F.wid == 0) {
        float gq = fabsf(gqn[F.lane]), gk = fabsf(gkn[F.lane]);
#pragma unroll
        for (int o = 1; o < 64; o <<= 1) { gq = fmaxf(gq, __int_as_float(__builtin_amdgcn_ds_bpermute((F.lane ^ o) << 2, __float_as_int(gq)))); gk = fmaxf(gk, __int_as_float(__builtin_amdgcn_ds_bpermute((F.lane ^ o) << 2, __float_as_int(gk)))); }
        if (F.lane == 0) wsum[8] = 150.0f + 2.0f * 1.03f * (QSCALE * 64.0f * gq * gk); }
    __syncthreads();
}
__device__ __forceinline__ int fox_tstart(const Frame& F, int qb) {
    const LAS u32x2* krec = (const LAS u32x2*)(F.lds + FOX_KB); const float thr = ((const LAS float*)(F.lds + FOX_SCAN))[8];
    const u32x2 rq = krec[qb * 256]; const float kq = (bf_lo(rq.x) + bf_hi(rq.x)) + bf_lo(rq.y); int t = 0;
    while (t < 4 * qb) { const u32x2 rk = krec[64 * t + 63]; if (!(kq - ((bf_lo(rk.x) + bf_hi(rk.x)) + bf_lo(rk.y)) > thr)) break; ++t; }
    return t & ~1;
}

constexpr int PH_PER_LAYER = 9;
__device__ __forceinline__ void run_phase(const Frame& F, int ph, int layer) {
    CParams& p = *F.p; const int j = layer >> 1; const bool odd = layer & 1;
    if (ph == 0) { p0_prologue(F); return; }
    if (ph == 1) {
        if (odd) { const Frame F1 = F.fresh(); logf_units(F1, j); }
        pg8::SchedStd S; S.A = (const char*)F.x0(); S.lda = D; S.K = D; S.nM = T / 256; S.G = F.G; S.c = F.bid;
        pg8::EpiInProj E; E.out = F.r1(); E.rtab = (const LAS float*)(F.lds + RSTD_TAB); E.odd = odd ? 1 : 0;
        if (odd) { S.B = (const char*)F.wt(WO_IN + (size_t)j * ODD_N * D); S.nN = ODD_N / 256; E.ldo = ODD_N; E.g0 = p.in[11] + j * 64; E.g1 = p.in[12] + j * 64; }
        else { S.B = (const char*)F.wt(WE_IN + (size_t)j * EVEN_IN * D); S.nN = EVEN_IN / 256; E.ldo = EVEN_IN; E.g0 = p.in[7] + (size_t)j * 8 * 64; E.g1 = nullptr; }
        { const Frame F1 = F.fresh(); LAS float* tab = (LAS float*)(F1.lds + RSTD_TAB); const float* ssA = F1.smf(SM_SSA);
          for (int idx = F1.tid; idx < 5 * 256; idx += NTHREADS) { pg8::Unit u; if (S.next(idx >> 8, u)) tab[idx] = rstd_from16(ssA + (size_t)(u.pm * 256 + (idx & 255)) * 16); }
          __syncthreads(); }
        pg8::gemm_phase(F.lds, S, E, D, F.tid);
        return; }
    if (ph == 2) {
        if (!odd) {
#pragma unroll 1
            for (int rp = 0; rp < 1 + (PROBE2 & 1); ++rp) { const Frame F1 = F.fresh(); for (int u = F1.bid; u < 256; u += F1.G) sgu_unit(F1, j, u); }
#pragma unroll 1
            for (int rp = 0; rp < 1 + ((PROBE2 >> 1) & 1); ++rp) {
            const Frame F2 = F.fresh();
            const bf16_t* pr = F2.r1();
            __syncthreads();
            for (int u = F2.bid * 8 + F2.wid; u < 8192; u += F2.G * 8) sb_wave_unit(F2, pr + 1024, pr + 1536, pr + 2048, EVEN_IN, F2.ybuf() + 512, D, u >> 10, (u >> 7) & 7, u & 127);
            __syncthreads(); }
        } else {
            const attn_body::bf16* pr = (const attn_body::bf16*)F.r1();
#pragma unroll 1
            for (int rp = 0; rp < 1 + ((PROBE2 >> 2) & 1); ++rp)
            for (int c = F.bid; c < 256; c += F.G) {
                const int bb = c >> 5, aa = (c >> 3) & 3, h0 = c & 7;
#pragma unroll 1
                for (int i = 0; i < 4; ++i) { const int qb = i == 0 ? aa : i == 1 ? 7 - aa : i == 2 ? 8 + aa : 15 - aa; const int hd = (h0 + 2 * i) & 7;
                    { const Frame F1 = F.fresh(); fox_kbias(F1, bb, hd, F1.smf(SM_LOGF), p.in[11] + j * 64, p.in[12] + j * 64); }
                    const Frame F2 = F.fresh();
                    attn_body::attn_unit<64>(bb, hd, qb, pr, pr + 512, pr + 1024, (attn_body::bf16*)F2.ybuf(), (char*)F2.lds, (const char*)F2.lds + FOX_KB, F2.tid, fox_tstart(F2, qb)); }
            }
#pragma unroll 1
            for (int rp = 0; rp < 1 + ((PROBE2 >> 3) & 1); ++rp) { const Frame F3 = F.fresh(); for (int u = F3.bid; u < 256; u += F3.G) pool_unit(F3, j, u); }
        }
        return; }
    if (ph == 3) {
        pg8::SchedStd S; S.A = (const char*)F.ybuf(); S.lda = D; S.K = D; S.nM = T / 256; S.nN = 4; S.G = F.G; S.c = F.bid;
        S.B = (const char*)(odd ? F.wt(WO_OUT + (size_t)j * D * D) : F.wt(WE_OUT + (size_t)j * D * D));
        pg8::EpiResid E; E.hin = F.x0(); E.hb = F.hb(); E.ss = F.smf(SM_SSB);
        pg8::gemm_phase(F.lds, S, E, D, F.tid);
        return; }
    if (ph == 4) { router_phase(F, layer); return; }
    if (ph == 5) { scatter_phase(F); return; }
    if (ph == 6) {
        int n_up;
        { pg8::SchedUp S; S.init(F.smi(SM_EBASE), F.G, F.bid, 2); S.A = (const char*)F.hb(); S.B = (const char*)F.wt(WL_UP + (size_t)layer * NEXP * 512 * D); S.rowtok = F.smi(SM_ROWTOK); S.K = D;
          n_up = S.total_rt * 2;
          pg8::EpiUp E; E.act = F.r2(); E.rowtok = F.smi(SM_ROWTOK); E.roww = F.smf(SM_ROWW); E.rowrs = F.smf(SM_ROWRS);
          pg8::gemm_phase(F.lds, S, E, D, F.tid); }
        { const Frame F1 = F.fresh();
          const int rem = n_up % F1.G, nlight = rem ? F1.G - rem : F1.G, v = rem ? (F1.bid - rem) : F1.bid;
          pg8::SchedStd S; S.A = (const char*)F1.ybuf(); S.lda = PLE; S.K = PLE; S.nM = T / 256; S.nN = 4; S.G = nlight; S.c = v >= 0 ? v : 0x40000000;
          S.B = (const char*)F1.wt(WL_PP + (size_t)layer * D * PLE);
          pg8::EpiEproj E; E.eraw = F1.r3(); E.ss = F1.smf(SM_SSE);
          pg8::gemm_phase(F1.lds, S, E, PLE, F1.tid); }
        return; }
    if (ph == 7) {
        pg8::SchedDown S; S.init(F.smi(SM_EBASE), F.G, F.bid, 4); S.A = (const char*)F.r2(); S.B = (const char*)F.wt(WL_DN + (size_t)layer * NEXP * D * DEXP); S.K = DEXP;
        pg8::EpiDown E; E.Y = F.r1(); E.rowtok = F.smi(SM_ROWTOK);
        pg8::gemm_phase(F.lds, S, E, DEXP, F.tid);
        return; }
    if (ph == 8) { combine_phase(F); return; }
    if (ph == 9) {
        pg8::SchedStd S; S.A = (const char*)F.hb(); S.lda = D; S.K = D; S.nM = T / 256; S.nN = 4; S.G = F.G; S.c = F.bid;
        S.B = (const char*)F.wt(WL_PG + (size_t)layer * D * D);
        pg8::EpiPle E; E.h = F.hb(); E.xn = F.x0(); E.fout = layer == 3 ? p.out : nullptr; E.ss = F.smf(SM_SSA); E.rstd2 = F.smf(SM_RSTD2); E.rstdE = F.smf(SM_RSTDE); E.eraw = F.r3(); E.gE = p.in[24] + layer * D;
        pg8::gemm_phase(F.lds, S, E, D, F.tid);
        return; }
}

template <int PH> __global__ void __launch_bounds__(NTHREADS, 2) k_phase(Params p, int layer) {
    extern __shared__ __attribute__((aligned(16))) unsigned char lds_raw[];
    Frame F; F.p = (CParams*)__builtin_amdgcn_kernarg_segment_ptr(); F.ws = p.ws; F.lds = (LAS unsigned char*)lds_raw; F.tid = threadIdx.x; F.lane = F.tid & 63; F.wid = __builtin_amdgcn_readfirstlane(F.tid >> 6); F.G = gridDim.x; F.bid = blockIdx.x;
    run_phase(F, PH, layer);
}

template <int PH> static void launch_phase(const Params& p, int layer, int grid, hipStream_t stream) {
    static bool attr = false;
    if (!attr) { (void)hipFuncSetAttribute((const void*)k_phase<PH>, hipFuncAttributeMaxDynamicSharedMemorySize, LDS_BYTES); attr = true; }
    hipLaunchKernelGGL((k_phase<PH>), dim3(grid), dim3(NTHREADS), LDS_BYTES, stream, p, layer);
}

constexpr int CW_BAR = 1024;
#define MEGA_PHASE(ph) do { int tb_ = 1; _Pragma("unroll 1") for (int rep_ = 0; rep_ < 1 + ((PROBE_MASK >> (ph)) & 1); ++rep_) { \
        CParams* q_ = pp; int t_, w_ = wid0, g_ = (int)gridDim.x, b_ = (int)blockIdx.x; asm volatile("v_mbcnt_lo_u32_b32 %1, -1, 0\n\tv_mbcnt_hi_u32_b32 %1, -1, %1\n\tv_lshl_add_u32 %1, %4, 6, %1" : "+s"(q_), "=&v"(t_), "+s"(g_), "+s"(b_) : "s"(w_)); \
        Frame F; F.p = q_; F.ws = q_->ws; F.lds = (LAS unsigned char*)lds_raw; F.tid = t_; F.lane = t_ & 63; F.wid = __builtin_amdgcn_readfirstlane(t_ >> 6); F.G = g_; F.bid = b_; \
        run_phase(F, ph, layer); } \
        asm volatile("v_mbcnt_lo_u32_b32 %0, -1, 0\n\tv_mbcnt_hi_u32_b32 %0, -1, %0\n\tv_lshl_add_u32 %0, %1, 6, %0" : "=&v"(tb_) : "s"(wid0)); \
        { XcdBarrier b_; b_.bar = (unsigned*)(pp->ws + WS_CTL) + CW_BAR; b_.x = barx; b_.st = st; asm volatile("" : "+s"(b_.x)); xcd_barrier(b_, tb_ == 0); if (PROBE_BAR) xcd_barrier(b_, tb_ == 0); } } while (0)
__global__ void __launch_bounds__(NTHREADS, 2) k_mega(Params p) {
    extern __shared__ __attribute__((aligned(16))) unsigned char lds_raw[];
    CParams* pp = (CParams*)__builtin_amdgcn_kernarg_segment_ptr();
    volatile LAS unsigned* st = (volatile LAS unsigned*)((LAS unsigned char*)lds_raw + MISC_OFF);
    const int wid0 = __builtin_amdgcn_readfirstlane((int)threadIdx.x >> 6);
    if (threadIdx.x < 4) st[threadIdx.x] = 0u;
    __syncthreads();
    const unsigned barx = xcd_barrier_post((unsigned*)(pp->ws + WS_CTL) + CW_BAR, st).x;
    { const int layer = 0; MEGA_PHASE(0); }
#pragma unroll 1
    for (int layer = 0; layer < 4; ++layer) {
        MEGA_PHASE(1); MEGA_PHASE(2); MEGA_PHASE(3); MEGA_PHASE(4); MEGA_PHASE(5); MEGA_PHASE(6); MEGA_PHASE(7); MEGA_PHASE(8); MEGA_PHASE(9);
    }
}

extern "C" void kernel_launch(void* const* d_in, const int* in_sizes, int n_in, void* d_out, int out_size, void* d_ws, size_t ws_size, hipStream_t stream) {
    if (n_in != 26 || out_size != T * D || ws_size < WS_END) { fprintf(stderr, "kernel_launch: unexpected shapes (n_in %d, out %d, ws %zu, need %zu)\n", n_in, out_size, ws_size, (size_t)WS_END); return; }
    Params p{};
    for (int i = 0; i < 26; ++i) p.in[i] = (const float*)d_in[i];
    p.out = (float*)d_out; p.ws = (unsigned char*)d_ws;
    (void)hipMemsetAsync((char*)d_ws + WS_CTL, 0, 65536, stream);
#if MEGA
    static int grid = 0;
    if (!grid) {
        int dev = 0, cus = 0, per_cu = 0;
        (void)hipGetDevice(&dev); (void)hipDeviceGetAttribute(&cus, hipDeviceAttributeMultiprocessorCount, dev);
        (void)hipFuncSetAttribute((const void*)k_mega, hipFuncAttributeMaxDynamicSharedMemorySize, LDS_BYTES);
        (void)hipOccupancyMaxActiveBlocksPerMultiprocessor(&per_cu, k_mega, NTHREADS, LDS_BYTES);
        if (per_cu < 1) { fprintf(stderr, "kernel_launch: occupancy query says %d blocks per CU\n", per_cu); per_cu = 1; }
        grid = cus > 0 ? cus : 256;
    }
    hipLaunchKernelGGL(k_mega, dim3(grid), dim3(NTHREADS), LDS_BYTES, stream, p);
#else
    const int grid = 256;
    launch_phase<0>(p, 0, grid, stream);
    for (int layer = 0; layer < 4; ++layer) {
        launch_phase<1>(p, layer, grid, stream); launch_phase<2>(p, layer, grid, stream); launch_phase<3>(p, layer, grid, stream);
        launch_phase<4>(p, layer, grid, stream); launch_phase<5>(p, layer, grid, stream); launch_phase<6>(p, layer, grid, stream);
        launch_phase<7>(p, layer, grid, stream); launch_phase<8>(p, layer, grid, stream); launch_phase<9>(p, layer, grid, stream);
    }
#endif
}
```

```cpp
#include <hip/hip_runtime.h>
#include <cstdio>
#include <cstdint>

#ifndef MEGA
#define MEGA 1
#endif
#ifndef PROBE2
#define PROBE2 0
#endif
#ifndef PROBE_BAR
#define PROBE_BAR 0
#endif
#ifndef PROBE_MASK
#define PROBE_MASK 0
#endif

#define LAS __attribute__((address_space(3)))
typedef unsigned short bf16_t;
typedef short bf16x8 __attribute__((ext_vector_type(8)));
typedef short s16x4 __attribute__((ext_vector_type(4)));
typedef float f32x4 __attribute__((ext_vector_type(4)));
typedef float f32x2 __attribute__((ext_vector_type(2)));
typedef float f32x16 __attribute__((ext_vector_type(16)));
typedef unsigned u32x4 __attribute__((ext_vector_type(4)));
typedef unsigned u32x2 __attribute__((ext_vector_type(2)));

constexpr int T = 32768, D = 1024, SEQ = 4096, NBATCH = 8;
constexpr int EVEN_IN = 2560, ODD_IN = 2056, ODD_N = 2048;
constexpr int NEXP = 16, DEXP = 256, PLE = 256;
constexpr float EPS = 1e-6f;
constexpr float LOG2E = 1.4426950408889634f;
constexpr float QSCALE = 0.125f * LOG2E;
constexpr int NTHREADS = 512;
constexpr int ROWCAP = 65536 + 4096;

constexpr size_t MiB = 1u << 20;
constexpr size_t WS_CTL = 0, CTL_BYTES = 1 * MiB;
constexpr size_t WS_HB = 1 * MiB;
constexpr size_t WS_R1 = 65 * MiB;
constexpr size_t WS_R2 = 225 * MiB;
constexpr size_t WS_R3 = 289 * MiB;
constexpr size_t WS_SM = 353 * MiB;
constexpr size_t WS_W = 369 * MiB;
constexpr size_t SM_SSA = 0, SM_SSB = 2 * MiB, SM_SSE = 4 * MiB, SM_RSTD1 = 6 * MiB, SM_RSTD2 = 6 * MiB + 131072, SM_RSTDE = 15 * MiB,
                 SM_TOKREC = 6 * MiB + 262144, SM_LOGF = 7 * MiB, SM_COUNTS = 8 * MiB, SM_LISTS = 8 * MiB + 65536,
                 SM_ROWTOK = 11 * MiB, SM_ROWW = 11 * MiB + 524288, SM_ROWRS = 12 * MiB, SM_EBASE = 12 * MiB + 524288,
                 SM_WF = 13 * MiB, SM_WFB = 13 * MiB + 524288, SM_RWB = 14 * MiB;
constexpr size_t WE_IN = 0;
constexpr size_t WE_OUT = WE_IN + 2 * (size_t)EVEN_IN * D;
constexpr size_t WE_SGU = WE_OUT + 2 * (size_t)D * D;
constexpr size_t WO_IN = WE_SGU + 2 * (size_t)8 * 128 * 128;
constexpr size_t WO_OUT = WO_IN + 2 * (size_t)ODD_N * D;
constexpr size_t WO_POOL = WO_OUT + 2 * (size_t)D * D;
constexpr size_t WL_UP = WO_POOL + 2 * (size_t)4 * 128 * 128;
constexpr size_t WL_DN = WL_UP + 4 * (size_t)NEXP * 512 * D;
constexpr size_t WL_PP = WL_DN + 4 * (size_t)NEXP * D * DEXP;
constexpr size_t WL_PG = WL_PP + 4 * (size_t)D * PLE;
constexpr size_t W_END = WL_PG + 4 * (size_t)D * D;
constexpr size_t WS_END = WS_W + W_END * 2;
static_assert(WS_END <= 512 * MiB, "workspace map exceeds 512 MiB");

constexpr int CW_QUEUE = 8192;
constexpr int RING_BYTES = 131072;
constexpr int MISC_OFF = RING_BYTES;
constexpr int RSTD_TAB = MISC_OFF + 256;
constexpr int LDS_BYTES = RING_BYTES + 8192;

struct Params { const float* in[26]; float* out; unsigned char* ws; };
typedef const __attribute__((address_space(4))) Params CParams;

__device__ __forceinline__ unsigned cvt_pk_bf16(float lo, float hi) { unsigned r; asm volatile("v_cvt_pk_bf16_f32 %0, %1, %2" : "=v"(r) : "v"(lo), "v"(hi)); return r; }
__device__ __forceinline__ float bf_lo(unsigned w) { return __uint_as_float(w << 16); }
__device__ __forceinline__ float bf_hi(unsigned w) { return __uint_as_float(w & 0xffff0000u); }
__device__ __forceinline__ float fast_exp2(float x) { return __builtin_amdgcn_exp2f(x); }
__device__ __forceinline__ float fast_rcp(float x) { return __builtin_amdgcn_rcpf(x); }
__device__ __forceinline__ float gelu_tanh(float x) { const float t = x * (1.0f + 0.044715f * x * x); return x * fast_rcp(1.0f + fast_exp2(-2.302208198f * t)); }
__device__ __forceinline__ float sigmoid_f(float x) { return fast_rcp(1.0f + fast_exp2(-LOG2E * x)); }
__device__ __forceinline__ float rstd_from16(const float* ss16) {
    const f32x4 a = *(const f32x4*)(ss16), b = *(const f32x4*)(ss16 + 4), c = *(const f32x4*)(ss16 + 8), d = *(const f32x4*)(ss16 + 12);
    const float s = ((a[0] + a[1]) + (a[2] + a[3])) + ((b[0] + b[1]) + (b[2] + b[3])) + ((c[0] + c[1]) + (c[2] + c[3])) + ((d[0] + d[1]) + (d[2] + d[3]));
    return 1.0f / sqrtf(s * (1.0f / 1024.0f) + EPS);
}
__device__ __forceinline__ float sum_x32(float x) { const auto rr = __builtin_amdgcn_permlane32_swap(__float_as_uint(x), __float_as_uint(x), false, false); return __uint_as_float(rr[0]) + __uint_as_float(rr[1]); }
__device__ __forceinline__ float max_x32(float x) { const auto rr = __builtin_amdgcn_permlane32_swap(__float_as_uint(x), __float_as_uint(x), false, false); return fmaxf(__uint_as_float(rr[0]), __uint_as_float(rr[1])); }
__device__ __forceinline__ float other_x32(float x, int hh) { const auto rr = __builtin_amdgcn_permlane32_swap(__float_as_uint(x), __float_as_uint(x), false, false); return __uint_as_float(hh ? rr[0] : rr[1]); }
__device__ __forceinline__ float sum_x16(float x) { const auto rr = __builtin_amdgcn_permlane16_swap(__float_as_uint(x), __float_as_uint(x), false, false); return __uint_as_float(rr[0]) + __uint_as_float(rr[1]); }
template <int CTRL> __device__ __forceinline__ float dpp_f(float x) { return __int_as_float(__builtin_amdgcn_update_dpp(0, __float_as_int(x), CTRL, 0xf, 0xf, true)); }
__device__ __forceinline__ float sum_row16(float x) { x += dpp_f<0xB1>(x); x += dpp_f<0x4E>(x); x += dpp_f<0x124>(x); x += dpp_f<0x128>(x); return x; }
__device__ __forceinline__ float wave_sum(float x) { return sum_x32(sum_x16(sum_row16(x))); }
typedef short v4i16_t __attribute__((ext_vector_type(4)));
__device__ __forceinline__ s16x4 tr_read(LAS unsigned char* p) { return __builtin_bit_cast(s16x4, __builtin_amdgcn_ds_read_tr16_b64_v4i16((LAS v4i16_t*)p)); }
#define MFMA32(a, b, c) __builtin_amdgcn_mfma_f32_32x32x16_bf16((a), (b), (c), 0, 0, 0)

#define XB_TMO      128
#define XB_XCNT(j)  (256  + 64 * (j))
#define XB_XSUB(j)  (1280 + 64 * (j))
#define XB_XGEN(j)  (2304 + 64 * (j))
#define XB_TOP      3328
#define XB_TOPGEN   3392
#define XCD_BAR_WORDS 3456
#define XB_SPIN_CAP (1u << 18)
__device__ __forceinline__ unsigned xb_ld(unsigned* p)              { return __hip_atomic_load(p, __ATOMIC_RELAXED, __HIP_MEMORY_SCOPE_AGENT); }
__device__ __forceinline__ unsigned xb_add(unsigned* p, unsigned v) { return __hip_atomic_fetch_add(p, v, __ATOMIC_RELAXED, __HIP_MEMORY_SCOPE_AGENT); }
__device__ __forceinline__ unsigned xb_xcc_id() { return (unsigned)__builtin_amdgcn_s_getreg((3 << 11) | 20) & 0xFu; }
#define XB_SPIN(cond, bar) do { unsigned _sp = 0; while (cond) { __builtin_amdgcn_s_sleep(1); \
    if ((++_sp & 255u) == 0u) { if (xb_ld(&(bar)[XB_TMO])) break; if (_sp > XB_SPIN_CAP) { atomicAdd(&(bar)[XB_TMO], 1u); break; } } } } while (0)
struct XcdBarrier { unsigned* bar; unsigned x; volatile LAS unsigned* st; };
__device__ __forceinline__ XcdBarrier xcd_barrier_post(unsigned* bar, volatile LAS unsigned* st) {
    XcdBarrier b; b.bar = bar; b.x = xb_xcc_id(); b.st = st;
    if (threadIdx.x == 0) (void)xb_add(&bar[XB_XCNT(b.x)], 1u);
    return b;
}
__device__ __forceinline__ void xcd_barrier_complete(unsigned* bar, unsigned x, unsigned& nloc, unsigned& nx) {
    const unsigned G = gridDim.x * gridDim.y * gridDim.z;
    unsigned sum, cnt, mine, sp = 0u;
    for (;;) {
        sum = 0u; cnt = 0u; mine = 0u;
#pragma unroll
        for (unsigned j = 0; j < 16; ++j) { const unsigned c = xb_ld(&bar[XB_XCNT(j)]); sum += c; cnt += (c > 0u) ? 1u : 0u; mine = (j == x) ? c : mine; }
        if (sum == G) break;
        __builtin_amdgcn_s_sleep(1);
        if ((++sp & 255u) == 0u) { if (xb_ld(&bar[XB_TMO])) break; if (sp > XB_SPIN_CAP) { atomicAdd(&bar[XB_TMO], 1u); break; } }
    }
    nloc = mine > 0u ? mine : 1u; nx = cnt > 0u ? cnt : 1u;
}
__device__ __forceinline__ void xcd_barrier(const XcdBarrier& b, const bool is_t0) {
    asm volatile("s_waitcnt vmcnt(0)" ::: "memory");
    __syncthreads();
    if (is_t0) {
        unsigned* bar = b.bar;
        __builtin_amdgcn_s_waitcnt(0);
        unsigned nloc = b.st[0], nx = b.st[1];
        if (nloc == 0u) { xcd_barrier_complete(bar, b.x, nloc, nx); b.st[0] = nloc; b.st[1] = nx; }
        const unsigned old = xb_add(&bar[XB_XSUB(b.x)], 1u);
        const unsigned gen = old / nloc;
        if (old + 1u == (gen + 1u) * nloc) {
            __builtin_amdgcn_fence(__ATOMIC_RELEASE, "agent");
            asm volatile("s_waitcnt vmcnt(0)" ::: "memory");
            const unsigned og = xb_add(&bar[XB_TOP], 1u);
            const unsigned tg = og / nx;
            if (og + 1u == (tg + 1u) * nx) xb_add(&bar[XB_TOPGEN], 1u);
            else XB_SPIN(xb_ld(&bar[XB_TOPGEN]) == tg, bar);
            __builtin_amdgcn_fence(__ATOMIC_ACQUIRE, "agent");
            xb_add(&bar[XB_XGEN(b.x)], 1u);
            asm volatile("s_waitcnt vmcnt(0)" ::: "memory");
        } else {
            XB_SPIN(xb_ld(&bar[XB_XGEN(b.x)]) == gen, bar);
            __builtin_amdgcn_fence(__ATOMIC_ACQUIRE, "agent");
            asm volatile("s_waitcnt vmcnt(0)" ::: "memory");
        }
    }
    __syncthreads();
}

namespace pg8 {
constexpr int BM = 256, BK = 64, HALF = 128, HTB = HALF * BK * 2, STAGE_BYTES = 8 * HTB, NXCD = 8, WGM = 8;
__device__ __forceinline__ int lds_byte(int r, int c) { const int st = (r >> 4) * 2 + (c >> 5), rr = r & 15, cc = c & 31, ob = rr * 64 + cc * 2; return st * 1024 + (ob ^ (((ob >> 9) & 1) << 5)); }
__device__ __forceinline__ void stage_rc(int b, int& R, int& C) { const int st = b / 1024, sb = b % 1024, swz = sb ^ (((sb >> 9) & 1) << 5); R = (st >> 1) * 16 + swz / 64; C = (st & 1) * 32 + (swz % 64) / 2; }
__device__ __forceinline__ int perm32(int rho) { const int n = rho >> 4, i = rho & 15; return 8 * (i >> 2) + 4 * n + (i & 3); }
__device__ __forceinline__ int headperm(int r) { return 64 * (r >> 5) + 8 * ((r >> 2) & 3) + 4 * ((r >> 4) & 1) + (r & 3); }

struct Unit { int pm, pn, e; };

__device__ __forceinline__ bool static_order(int i, int G, int c, int nM, int nN, Unit& u) {
    const int nwg = nM * nN; const long L = (long)i * G + c; if (L >= nwg) return false;
    int wgid = (int)L; { const int q = nwg / NXCD, r = nwg % NXCD, xcd = wgid % NXCD, off = wgid / NXCD; wgid = (xcd < r ? xcd * (q + 1) : r * (q + 1) + (xcd - r) * q) + off; }
    const int nig = WGM * nN, gid = wgid / nig, fm = gid * WGM, gsz = (nM - fm) < WGM ? (nM - fm) : WGM;
    u.pm = fm + ((wgid % nig) % gsz); u.pn = (wgid % nig) / gsz; u.e = i; return true;
}

struct SchedStd {
    static constexpr bool GATHER = false;
    const char* A; const char* B; int lda, K, nM, nN, G, c;
    __device__ __forceinline__ bool next(int i, Unit& u) const { return static_order(i, G, c, nM, nN, u); }
    __device__ __forceinline__ const char* a_base(const Unit& u) const { return A + (size_t)u.pm * 256 * lda * 2; }
    __device__ __forceinline__ const char* b_base(const Unit& u) const { return B + (size_t)u.pn * 256 * K * 2; }
    __device__ __forceinline__ void a_voff(const Unit&, int R0, int C0, int R1, int C1, unsigned (&vo)[2][2]) const {
        vo[0][0] = (unsigned)(R0 * lda + C0) * 2u; vo[0][1] = (unsigned)(R1 * lda + C1) * 2u;
        vo[1][0] = (unsigned)((R0 + 128) * lda + C0) * 2u; vo[1][1] = (unsigned)((R1 + 128) * lda + C1) * 2u; }
};
struct SchedMoE {
    const int* ebase; int G, c, npn, total_rt;
    __device__ __forceinline__ void init(const int* eb, int G_, int c_, int npn_) { ebase = eb; G = G_; c = c_; npn = npn_; total_rt = eb[16] >> 8; }
    __device__ __forceinline__ bool next_(int i, Unit& u) const {
        const int L = i * G + c; if (L >= total_rt * npn) return false;
        u.pm = L / npn; u.pn = L % npn; int e = 0;
#pragma unroll
        for (int j = 1; j < 16; ++j) e += (ebase[j] <= u.pm * 256) ? 1 : 0;
        u.e = e; return true; }
};
struct SchedUp : SchedMoE {
    static constexpr bool GATHER = true;
    const char* A; const char* B; const int* rowtok; int K;
    __device__ __forceinline__ bool next(int i, Unit& u) const { return next_(i, u); }
    __device__ __forceinline__ const char* a_base(const Unit&) const { return A; }
    __device__ __forceinline__ const char* b_base(const Unit& u) const { return B + ((size_t)u.e * 512 + (size_t)u.pn * 256) * 1024 * 2; }
    __device__ __forceinline__ void a_voff(const Unit& u, int R0, int C0, int R1, int C1, unsigned (&vo)[2][2]) const {
        const int* rt = rowtok + u.pm * 256;
        int t00 = rt[R0], t01 = rt[R1], t10 = rt[R0 + 128], t11 = rt[R1 + 128];
        t00 = t00 < 0 ? 0 : (t00 >> 1); t01 = t01 < 0 ? 0 : (t01 >> 1); t10 = t10 < 0 ? 0 : (t10 >> 1); t11 = t11 < 0 ? 0 : (t11 >> 1);
        vo[0][0] = (unsigned)(t00 * 1024 + C0) * 2u; vo[0][1] = (unsigned)(t01 * 1024 + C1) * 2u;
        vo[1][0] = (unsigned)(t10 * 1024 + C0) * 2u; vo[1][1] = (unsigned)(t11 * 1024 + C1) * 2u; }
};
struct SchedDown : SchedMoE {
    static constexpr bool GATHER = false;
    const char* A; const char* B; int K;
    __device__ __forceinline__ bool next(int i, Unit& u) const { return next_(i, u); }
    __device__ __forceinline__ const char* a_base(const Unit& u) const { return A + (size_t)u.pm * 256 * 256 * 2; }
    __device__ __forceinline__ const char* b_base(const Unit& u) const { return B + ((size_t)u.e * 1024 + (size_t)u.pn * 256) * 256 * 2; }
    __device__ __forceinline__ void a_voff(const Unit&, int R0, int C0, int R1, int C1, unsigned (&vo)[2][2]) const {
        vo[0][0] = (unsigned)(R0 * 256 + C0) * 2u; vo[0][1] = (unsigned)(R1 * 256 + C1) * 2u;
        vo[1][0] = (unsigned)((R0 + 128) * 256 + C0) * 2u; vo[1][1] = (unsigned)((R1 + 128) * 256 + C1) * 2u; }
};

template <class Epi, class Sched>
__device__ __forceinline__ void gemm_phase(LAS unsigned char* lds, const Sched& S, const Epi& E, const int K, const int tid) {
    const int wid = __builtin_amdgcn_readfirstlane(tid >> 6), lane = tid & 63, wr = wid >> 2, wc = wid & 3, fr = lane & 15, fq = lane >> 4;
    const int nt = K / BK;
    int R0, C0, R1, C1; stage_rc(tid * 16, R0, C0); stage_rc(tid * 16 + 8192, R1, C1);
    unsigned voffB[2];
    { const int Rb0 = Epi::BMODE == 1 ? ((R0 & ~31) + perm32(R0 & 31)) : Epi::BMODE == 2 ? headperm(R0) : R0;
      const int Rb1 = Epi::BMODE == 1 ? ((R1 & ~31) + perm32(R1 & 31)) : Epi::BMODE == 2 ? headperm(R1) : R1;
      voffB[0] = (unsigned)(Rb0 * K + C0) * 2u; voffB[1] = (unsigned)(Rb1 * K + C1) * 2u; }
    const size_t kstep = (size_t)(BK * 2);
    const size_t hstepB = (size_t)(Epi::BMODE == 2 ? 32 : HALF) * K * 2;
    const unsigned ldsw = (unsigned)wid * 1024u;
    const int aoff = lds_byte(wr * 64 + fr, fq * 8), boff = lds_byte(wc * 32 + fr, fq * 8);
#define PG8_SA(b, h) (((b) * 2 + (h)) * HTB)
#define PG8_SB(b, h) ((4 + (b) * 2 + (h)) * HTB)
#define PG8_STAGE(bufoff, gbase, voff) do { _Pragma("unroll") for (int _i = 0; _i < 2; ++_i) \
        __builtin_amdgcn_global_load_lds((const unsigned*)((const char*)(gbase) + (voff)[_i]), (LAS unsigned*)(lds + (bufoff) + ldsw + _i * 8192), 16, 0, 0); } while (0)
#define PG8_LDA(dst, b, h) do { _Pragma("unroll") for (int m = 0; m < 4; ++m) _Pragma("unroll") for (int k = 0; k < 2; ++k) dst[m][k] = *(const LAS bf16x8*)(lds + PG8_SA(b, h) + aoff + m * 2048 + k * 1024); } while (0)
#define PG8_LDB(dst, b, h) do { _Pragma("unroll") for (int n = 0; n < 2; ++n) _Pragma("unroll") for (int k = 0; k < 2; ++k) dst[n][k] = *(const LAS bf16x8*)(lds + PG8_SB(b, h) + boff + n * 2048 + k * 1024); } while (0)
#define PG8_MMA(ai, bj, At, Bt) do { __builtin_amdgcn_s_setprio(1); _Pragma("unroll") for (int m = 0; m < 4; ++m) _Pragma("unroll") for (int n = 0; n < 2; ++n) _Pragma("unroll") for (int k = 0; k < 2; ++k) \
        acc[ai][bj][m][n] = __builtin_amdgcn_mfma_f32_16x16x32_bf16(Bt[n][k], At[m][k], acc[ai][bj][m][n], 0, 0, 0); __builtin_amdgcn_s_setprio(0); } while (0)
#define PG8_WAIT_V(n) asm volatile("s_waitcnt vmcnt(" #n ")" ::: "memory")
#define PG8_WAIT_L(n) asm volatile("s_waitcnt lgkmcnt(" #n ")" ::: "memory")
#define PG8_BAR __builtin_amdgcn_s_barrier()
#define PG8_SCHED __builtin_amdgcn_sched_barrier(0)
    Unit cur, nxt; int ui = 0;
    if (!S.next(0, cur)) return;
    f32x4 acc[2][2][4][2];
#pragma unroll
    for (int a = 0; a < 2; ++a)
#pragma unroll
        for (int b = 0; b < 2; ++b)
#pragma unroll
            for (int m = 0; m < 4; ++m)
#pragma unroll
                for (int n = 0; n < 2; ++n) acc[a][b][m][n] = (f32x4){0.f, 0.f, 0.f, 0.f};
    bf16x8 At[4][2], B0[2][2], B1[2][2];
    const char* cA = S.a_base(cur); const char* cB = S.b_base(cur);
    unsigned voC[2][2], voN[2][2];
    S.a_voff(cur, R0, C0, R1, C1, voC);
    PG8_STAGE(PG8_SB(0, 0), cB, voffB); PG8_STAGE(PG8_SB(0, 1), cB + hstepB, voffB); PG8_STAGE(PG8_SA(0, 0), cA, voC[0]); PG8_STAGE(PG8_SA(0, 1), cA, voC[1]);
    if (wr == 1) PG8_BAR;
    PG8_WAIT_V(2); PG8_BAR;
    PG8_STAGE(PG8_SB(1, 0), cB + kstep, voffB); PG8_STAGE(PG8_SA(1, 0), cA + kstep, voC[0]); PG8_STAGE(PG8_SB(1, 1), cB + hstepB + kstep, voffB);
    PG8_WAIT_V(6); PG8_BAR;
    for (;;) {
        const bool has_next = S.next(ui + 1, nxt);
        const char* nA = has_next ? S.a_base(nxt) : cA; const char* nB = has_next ? S.b_base(nxt) : cB;
        if constexpr (Sched::GATHER) {
            if (has_next) { int t2 = tid; asm volatile("" : "+v"(t2));
                int Ra, Ca, Rb_, Cb_; stage_rc(t2 * 16, Ra, Ca); stage_rc(t2 * 16 + 8192, Rb_, Cb_); S.a_voff(nxt, Ra, Ca, Rb_, Cb_, voN); }
            else {
#pragma unroll
                for (int h = 0; h < 2; ++h)
#pragma unroll
                    for (int i = 0; i < 2; ++i) voN[h][i] = voC[h][i]; } }
#pragma unroll 1
        for (int t = 0; t < nt; t += 2) {
            const bool last = (t == nt - 2);
            const char* a1 = cA + (size_t)(t + 1) * kstep;
            const char* a2 = last ? nA : cA + (size_t)(t + 2) * kstep; const char* b2 = last ? nB : cB + (size_t)(t + 2) * kstep;
            const char* a3 = a2 + kstep; const char* b3 = b2 + kstep;
            PG8_LDB(B0, 0, 0); PG8_LDB(B1, 0, 1); PG8_SCHED; PG8_LDA(At, 0, 0); PG8_STAGE(PG8_SA(1, 1), a1, voC[1]);
            if constexpr (Sched::GATHER) {
#pragma unroll
                for (int h = 0; h < 2; ++h)
#pragma unroll
                    for (int i = 0; i < 2; ++i) voC[h][i] = last ? voN[h][i] : voC[h][i]; }
            PG8_WAIT_V(8); PG8_WAIT_L(0); PG8_BAR; PG8_MMA(0, 0, At, B0); PG8_MMA(0, 1, At, B1); PG8_BAR; PG8_SCHED;
            PG8_LDA(At, 0, 1); PG8_STAGE(PG8_SB(0, 0), b2, voffB); PG8_STAGE(PG8_SB(0, 1), b2 + hstepB, voffB); PG8_STAGE(PG8_SA(0, 0), a2, voC[0]);
            PG8_WAIT_V(8); PG8_WAIT_L(0); PG8_BAR; PG8_MMA(1, 0, At, B0); PG8_MMA(1, 1, At, B1); PG8_BAR; PG8_SCHED;
            PG8_LDB(B0, 1, 0); PG8_LDB(B1, 1, 1); PG8_SCHED; PG8_LDA(At, 1, 0); PG8_STAGE(PG8_SA(0, 1), a2, voC[1]);
            PG8_WAIT_V(8); PG8_WAIT_L(0); PG8_BAR; PG8_MMA(0, 0, At, B0); PG8_MMA(0, 1, At, B1); PG8_BAR; PG8_SCHED;
            PG8_LDA(At, 1, 1); PG8_STAGE(PG8_SB(1, 0), b3, voffB); PG8_STAGE(PG8_SB(1, 1), b3 + hstepB, voffB); PG8_STAGE(PG8_SA(1, 0), a3, voC[0]);
            PG8_WAIT_V(8); PG8_WAIT_L(0); PG8_BAR; PG8_MMA(1, 0, At, B0); PG8_MMA(1, 1, At, B1); PG8_BAR; PG8_SCHED;
        }
        if (wr == 0) PG8_BAR;
        { int fr_e = fr, fq_e = fq; asm volatile("" : "+v"(fr_e), "+v"(fq_e));
          E(acc, cur, wr, wc, fr_e, fq_e); }
        if (!has_next) break;
#pragma unroll
        for (int a = 0; a < 2; ++a)
#pragma unroll
            for (int b = 0; b < 2; ++b)
#pragma unroll
                for (int m = 0; m < 4; ++m)
#pragma unroll
                    for (int n = 0; n < 2; ++n) acc[a][b][m][n] = (f32x4){0.f, 0.f, 0.f, 0.f};
        cur = nxt; cA = nA; cB = nB; ++ui;
        if (wr == 1) PG8_BAR;
    }
    PG8_WAIT_V(0);
    PG8_BAR;
#undef PG8_SA
#undef PG8_SB
#undef PG8_STAGE
#undef PG8_LDA
#undef PG8_LDB
#undef PG8_MMA
#undef PG8_WAIT_V
#undef PG8_WAIT_L
#undef PG8_BAR
#undef PG8_SCHED
}

typedef f32x4 Acc[2][2][4][2];

struct EpiInProj {
    static constexpr int BMODE = 2;
    bf16_t* out; int ldo; const LAS float* rtab; const float* g0; const float* g1; int odd;
    __device__ __forceinline__ void operator()(const Acc& acc, const Unit& u, int wr, int wc, int fr, int fq) const {
        int mode; const float* gp = g0; float sc = 1.0f;
        if (odd) { mode = u.pn < 2 ? 3 : (u.pn < 4 ? 3 : 0); if (u.pn < 2) { gp = g0; sc = QSCALE; } else { gp = g1; sc = 1.0f; } }
        else { mode = u.pn < 2 ? 1 : (u.pn < 4 ? 2 : (u.pn < 6 ? 4 : 0)); sc = mode == 4 ? QSCALE : 1.0f; gp = g0 + (((u.pn - 2) & 1) * 4 + wc) * 64; }
        f32x4 gv[2][2];
        if (mode == 2 || mode == 3) {
#pragma unroll
            for (int bj = 0; bj < 2; ++bj)
#pragma unroll
                for (int n = 0; n < 2; ++n) gv[bj][n] = *(const f32x4*)(gp + 32 * bj + 8 * fq + 4 * n) * sc;
        } else {
#pragma unroll
            for (int bj = 0; bj < 2; ++bj)
#pragma unroll
                for (int n = 0; n < 2; ++n) gv[bj][n] = (f32x4){1.f, 1.f, 1.f, 1.f};
        }
#pragma unroll
        for (int ai = 0; ai < 2; ++ai)
#pragma unroll
            for (int m = 0; m < 4; ++m) {
                const int row = u.pm * 256 + ai * 128 + wr * 64 + m * 16 + fr;
                const float rs = rtab[u.e * 256 + ai * 128 + wr * 64 + m * 16 + fr];
                f32x4 v[2][2];
#pragma unroll
                for (int bj = 0; bj < 2; ++bj)
#pragma unroll
                    for (int n = 0; n < 2; ++n) v[bj][n] = acc[ai][bj][m][n] * rs;
                if (mode == 1 || mode == 2) {
#pragma unroll
                    for (int bj = 0; bj < 2; ++bj)
#pragma unroll
                        for (int n = 0; n < 2; ++n)
#pragma unroll
                            for (int e = 0; e < 4; ++e) v[bj][n][e] = gelu_tanh(v[bj][n][e]);
                }
                if (mode == 2 || mode == 3) {
                    float q = 0.f;
#pragma unroll
                    for (int bj = 0; bj < 2; ++bj)
#pragma unroll
                        for (int n = 0; n < 2; ++n) q += (v[bj][n][0] * v[bj][n][0] + v[bj][n][1] * v[bj][n][1]) + (v[bj][n][2] * v[bj][n][2] + v[bj][n][3] * v[bj][n][3]);
                    q = sum_x32(sum_x16(q));
                    const float hr = 1.0f / sqrtf(q * (1.0f / 64.0f) + EPS);
#pragma unroll
                    for (int bj = 0; bj < 2; ++bj)
#pragma unroll
                        for (int n = 0; n < 2; ++n) v[bj][n] = v[bj][n] * hr * gv[bj][n];
                } else if (mode == 4) {
#pragma unroll
                    for (int bj = 0; bj < 2; ++bj)
#pragma unroll
                        for (int n = 0; n < 2; ++n) v[bj][n] = v[bj][n] * sc;
                }
                bf16_t* rowp = out + (size_t)row * ldo + u.pn * 256 + wc * 64 + 8 * fq;
#pragma unroll
                for (int bj = 0; bj < 2; ++bj) {
                    u32x4 w; w.x = cvt_pk_bf16(v[bj][0][0], v[bj][0][1]); w.y = cvt_pk_bf16(v[bj][0][2], v[bj][0][3]); w.z = cvt_pk_bf16(v[bj][1][0], v[bj][1][1]); w.w = cvt_pk_bf16(v[bj][1][2], v[bj][1][3]);
                    *(u32x4*)(rowp + 32 * bj) = w; }
            }
    }
};

struct EpiResid {
    static constexpr int BMODE = 1;
    const bf16_t* hin; bf16_t* hb; float* ss;
    __device__ __forceinline__ void operator()(const Acc& acc, const Unit& u, int wr, int wc, int fr, int fq) const {
#pragma unroll
        for (int ai = 0; ai < 2; ++ai) {
            u32x4 hw[4][2];
#pragma unroll
            for (int m = 0; m < 4; ++m)
#pragma unroll
                for (int bj = 0; bj < 2; ++bj) hw[m][bj] = *(const u32x4*)(hin + (size_t)(u.pm * 256 + ai * 128 + wr * 64 + m * 16 + fr) * D + u.pn * 256 + bj * 128 + wc * 32 + 8 * fq);
            __builtin_amdgcn_sched_barrier(0);
#pragma unroll
            for (int m = 0; m < 4; ++m) {
                const int row = u.pm * 256 + ai * 128 + wr * 64 + m * 16 + fr; float q = 0.f;
#pragma unroll
                for (int bj = 0; bj < 2; ++bj) {
                    const size_t off = (size_t)row * D + u.pn * 256 + bj * 128 + wc * 32 + 8 * fq; const u32x4 h4 = hw[m][bj];
                    const f32x4 v0 = (f32x4){bf_lo(h4.x), bf_hi(h4.x), bf_lo(h4.y), bf_hi(h4.y)} + acc[ai][bj][m][0], v1 = (f32x4){bf_lo(h4.z), bf_hi(h4.z), bf_lo(h4.w), bf_hi(h4.w)} + acc[ai][bj][m][1];
                    u32x4 w; w.x = cvt_pk_bf16(v0[0], v0[1]); w.y = cvt_pk_bf16(v0[2], v0[3]); w.z = cvt_pk_bf16(v1[0], v1[1]); w.w = cvt_pk_bf16(v1[2], v1[3]);
                    *(u32x4*)(hb + off) = w;
                    q += (v0[0] * v0[0] + v0[1] * v0[1]) + (v0[2] * v0[2] + v0[3] * v0[3]) + (v1[0] * v1[0] + v1[1] * v1[1]) + (v1[2] * v1[2] + v1[3] * v1[3]); }
                q = sum_x32(sum_x16(q));
                if (fq == 0) ss[(size_t)row * 16 + u.pn * 4 + wc] = q;
            }
        }
    }
};
struct EpiPle {
    static constexpr int BMODE = 1;
    const bf16_t* h; bf16_t* xn; float* fout; float* ss; const float* rstd2; const float* rstdE; const bf16_t* eraw; const float* gE;
    __device__ __forceinline__ void operator()(const Acc& acc, const Unit& u, int wr, int wc, int fr, int fq) const {
        f32x4 gv[2][2];
#pragma unroll
        for (int bj = 0; bj < 2; ++bj)
#pragma unroll
            for (int n = 0; n < 2; ++n) gv[bj][n] = *(const f32x4*)(gE + u.pn * 256 + bj * 128 + wc * 32 + 8 * fq + 4 * n);
#pragma unroll
        for (int ap = 0; ap < 4; ++ap) { const int ai = ap >> 1, m0 = (ap & 1) * 2;
            u32x4 ewv[4][2], hwv[4][2]; float r2v[4], rEv[4];
#pragma unroll
            for (int m = m0; m < m0 + 2; ++m) { const int row = u.pm * 256 + ai * 128 + wr * 64 + m * 16 + fr; r2v[m] = rstd2[row]; rEv[m] = rstdE[row];
#pragma unroll
                for (int bj = 0; bj < 2; ++bj) { const size_t off = (size_t)row * D + u.pn * 256 + bj * 128 + wc * 32 + 8 * fq; ewv[m][bj] = *(const u32x4*)(eraw + off); hwv[m][bj] = *(const u32x4*)(h + off); } }
            __builtin_amdgcn_sched_barrier(0);
#pragma unroll
            for (int m = m0; m < m0 + 2; ++m) {
                const int row = u.pm * 256 + ai * 128 + wr * 64 + m * 16 + fr; float q = 0.f;
                const float r2 = r2v[m], rE = rEv[m];
#pragma unroll
                for (int bj = 0; bj < 2; ++bj) {
                    const size_t off = (size_t)row * D + u.pn * 256 + bj * 128 + wc * 32 + 8 * fq;
                    const u32x4 ew = ewv[m][bj], hw = hwv[m][bj];
                    f32x4 e0 = (f32x4){bf_lo(ew.x), bf_hi(ew.x), bf_lo(ew.y), bf_hi(ew.y)}, e1 = (f32x4){bf_lo(ew.z), bf_hi(ew.z), bf_lo(ew.w), bf_hi(ew.w)};
                    e0 = e0 * rE * gv[bj][0]; e1 = e1 * rE * gv[bj][1];
                    f32x4 g0, g1;
#pragma unroll
                    for (int e = 0; e < 4; ++e) { g0[e] = sigmoid_f(acc[ai][bj][m][0][e] * r2); g1[e] = sigmoid_f(acc[ai][bj][m][1][e] * r2); }
                    const f32x4 v0 = (f32x4){bf_lo(hw.x), bf_hi(hw.x), bf_lo(hw.y), bf_hi(hw.y)} + g0 * e0, v1 = (f32x4){bf_lo(hw.z), bf_hi(hw.z), bf_lo(hw.w), bf_hi(hw.w)} + g1 * e1;
                    if (fout) { *(f32x4*)(fout + off) = v0; *(f32x4*)(fout + off + 4) = v1; }
                    else { u32x4 w; w.x = cvt_pk_bf16(v0[0], v0[1]); w.y = cvt_pk_bf16(v0[2], v0[3]); w.z = cvt_pk_bf16(v1[0], v1[1]); w.w = cvt_pk_bf16(v1[2], v1[3]);
                        *(u32x4*)(xn + off) = w; }
                    q += (v0[0] * v0[0] + v0[1] * v0[1]) + (v0[2] * v0[2] + v0[3] * v0[3]) + (v1[0] * v1[0] + v1[1] * v1[1]) + (v1[2] * v1[2] + v1[3] * v1[3]); }
                q = sum_x32(sum_x16(q));
                if (fq == 0) ss[(size_t)row * 16 + u.pn * 4 + wc] = q;
            }
        }
    }
};
struct EpiEproj {
    static constexpr int BMODE = 1;
    bf16_t* eraw; float* ss;
    __device__ __forceinline__ void operator()(const Acc& acc, const Unit& u, int wr, int wc, int fr, int fq) const {
#pragma unroll
        for (int ai = 0; ai < 2; ++ai)
#pragma unroll
            for (int m = 0; m < 4; ++m) {
                const int row = u.pm * 256 + ai * 128 + wr * 64 + m * 16 + fr; float q = 0.f;
#pragma unroll
                for (int bj = 0; bj < 2; ++bj) {
                    const size_t off = (size_t)row * D + u.pn * 256 + bj * 128 + wc * 32 + 8 * fq;
                    const f32x4 v0 = acc[ai][bj][m][0], v1 = acc[ai][bj][m][1];
                    u32x4 w; w.x = cvt_pk_bf16(v0[0], v0[1]); w.y = cvt_pk_bf16(v0[2], v0[3]); w.z = cvt_pk_bf16(v1[0], v1[1]); w.w = cvt_pk_bf16(v1[2], v1[3]);
                    *(u32x4*)(eraw + off) = w;
                    q += (v0[0] * v0[0] + v0[1] * v0[1]) + (v0[2] * v0[2] + v0[3] * v0[3]) + (v1[0] * v1[0] + v1[1] * v1[1]) + (v1[2] * v1[2] + v1[3] * v1[3]); }
                q = sum_x32(sum_x16(q));
                if (fq == 0) ss[(size_t)row * 16 + u.pn * 4 + wc] = q;
            }
    }
};
struct EpiUp {
    static constexpr int BMODE = 1;
    bf16_t* act; const int* rowtok; const float* roww; const float* rowrs;
    __device__ __forceinline__ void operator()(const Acc& acc, const Unit& u, int wr, int wc, int fr, int fq) const {
        int tk[2][4]; float rsv[2][4], gwv[2][4];
#pragma unroll
        for (int ai = 0; ai < 2; ++ai)
#pragma unroll
            for (int m = 0; m < 4; ++m) { const int sr = u.pm * 256 + ai * 128 + wr * 64 + m * 16 + fr; tk[ai][m] = rowtok[sr]; rsv[ai][m] = rowrs[sr]; gwv[ai][m] = roww[sr]; }
        __builtin_amdgcn_sched_barrier(0);
#pragma unroll
        for (int ai = 0; ai < 2; ++ai)
#pragma unroll
            for (int m = 0; m < 4; ++m) {
                const int sr = u.pm * 256 + ai * 128 + wr * 64 + m * 16 + fr;
                if (tk[ai][m] < 0) continue;
                const float rs = rsv[ai][m], gw = gwv[ai][m];
                float o[8];
#pragma unroll
                for (int n = 0; n < 2; ++n)
#pragma unroll
                    for (int e = 0; e < 4; ++e) { const float g = acc[ai][0][m][n][e] * rs, uu = acc[ai][1][m][n][e] * rs; o[4 * n + e] = g * sigmoid_f(g) * uu * gw; }
                u32x4 w; w.x = cvt_pk_bf16(o[0], o[1]); w.y = cvt_pk_bf16(o[2], o[3]); w.z = cvt_pk_bf16(o[4], o[5]); w.w = cvt_pk_bf16(o[6], o[7]);
                *(u32x4*)(act + (size_t)sr * 256 + u.pn * 128 + wc * 32 + 8 * fq) = w;
            }
    }
};
struct EpiDown {
    static constexpr int BMODE = 1;
    bf16_t* Y; const int* rowtok;
    __device__ __forceinline__ void operator()(const Acc& acc, const Unit& u, int wr, int wc, int fr, int fq) const {
        int tk[2][4];
#pragma unroll
        for (int ai = 0; ai < 2; ++ai)
#pragma unroll
            for (int m = 0; m < 4; ++m) tk[ai][m] = rowtok[u.pm * 256 + ai * 128 + wr * 64 + m * 16 + fr];
        __builtin_amdgcn_sched_barrier(0);
#pragma unroll
        for (int ai = 0; ai < 2; ++ai)
#pragma unroll
            for (int m = 0; m < 4; ++m) {
                const int it = tk[ai][m];
                if (it < 0) continue;
                bf16_t* rowp = Y + ((size_t)(it & 1) * T + (size_t)(it >> 1)) * D + u.pn * 256 + wc * 32 + 8 * fq;
#pragma unroll
                for (int bj = 0; bj < 2; ++bj) {
                    const f32x4 v0 = acc[ai][bj][m][0], v1 = acc[ai][bj][m][1];
                    u32x4 w; w.x = cvt_pk_bf16(v0[0], v0[1]); w.y = cvt_pk_bf16(v0[2], v0[3]); w.z = cvt_pk_bf16(v1[0], v1[1]); w.w = cvt_pk_bf16(v1[2], v1[3]);
                    *(u32x4*)(rowp + bj * 128) = w; }
            }
    }
};
}

#include <hip/hip_bf16.h>
#include <cmath>
namespace attn_body {
using bf16=__hip_bfloat16;
using bf16x8=__attribute__((ext_vector_type(8)))short;
using s16x4=__attribute__((ext_vector_type(4)))short;
using f32x16=__attribute__((ext_vector_type(16)))float;
using f32x4=__attribute__((ext_vector_type(4)))float;
using u32x4=__attribute__((ext_vector_type(4)))unsigned;
using u32x2=__attribute__((ext_vector_type(2)))unsigned;
constexpr int BATCH=8,NHEAD=8,SEQ=4096,D=64,DM=2048,DMO=1024;
constexpr int NW=8,QBLK=32,QB=QBLK*NW,KVBLK=64,NQB=SEQ/QB;
constexpr int ATTN_UNIT_ROWS=QB;
__device__ __forceinline__ int crow(int r,int hi){return (r&3)+8*(r>>2)+4*hi;}
#define SBAR() __builtin_amdgcn_sched_barrier(0)
__device__ __forceinline__ void cmask(f32x16&p0,f32x16&p1,int jb,int qrel,int hi){
  const float NEG=-INFINITY; const int lim=qrel-(64*jb+4*hi);
  #pragma unroll
  for(int r=0;r<16;++r){const int kc=(r&3)+8*(r>>2); if(kc>lim)p0[r]=NEG; if(kc+32>lim)p1[r]=NEG;}
}

constexpr int NSLOT=3, SLOTB=8192;
constexpr int LDS_K=0, LDS_V=NSLOT*SLOTB, LDS_WS=2*NSLOT*SLOTB, LDS_OST=LDS_WS+NW*64*4, LDS_BYTES=LDS_OST+NW*4096;
constexpr float C2=0.125f*1.4426950408889634f;
__device__ __forceinline__ void glds16(const void*gsrc,unsigned lds_dst){unsigned keep;
  asm volatile("s_mov_b32 %0, m0\n\ts_mov_b32 m0, %2\n\ts_nop 0\n\tglobal_load_lds_dwordx4 %1, off\n\ts_mov_b32 m0, %0":"=&s"(keep):"v"(gsrc),"s"(lds_dst):"memory");}
__device__ __forceinline__ float max3f(float a,float b,float c){float r;asm("v_max3_f32 %0, %1, %2, %3":"=v"(r):"v"(a),"v"(b),"v"(c));return r;}
__device__ __forceinline__ float max2f(float a,float b){float r;asm("v_max_f32_e32 %0, %1, %2":"=v"(r):"v"(a),"v"(b));return r;}
__device__ __forceinline__ float fadd_s(float a,float b){float r;asm("v_add_f32_e32 %0, %1, %2":"=v"(r):"v"(a),"v"(b));return r;}
__device__ __forceinline__ float fsub_s(float a,float b){float r;asm("v_sub_f32_e32 %0, %1, %2":"=v"(r):"v"(a),"v"(b));return r;}
typedef float f32x2_t __attribute__((ext_vector_type(2))); typedef __bf16 bf16x2_t __attribute__((ext_vector_type(2)));
__device__ __forceinline__ unsigned cvtpk_s(float lo,float hi){f32x2_t v={lo,hi};bf16x2_t b=__builtin_convertvector(v,bf16x2_t);return __builtin_bit_cast(unsigned,b);}
#define WAIT_BAR(N) asm volatile("s_waitcnt vmcnt(" #N ") lgkmcnt(0)\n\ts_barrier":::"memory")

__device__ __forceinline__ void qkt(f32x16&p0,f32x16&p1,const char*Kslot,const bf16x8*qr,int r32,int hi,bf16x8 ka0,bf16x8 ka1,bf16x8 qaug){
  const char*kb=Kslot+hi*1024+r32*16;
  p0=__builtin_amdgcn_mfma_f32_32x32x16_bf16(ka0,qaug,f32x16{},0,0,0);p1=__builtin_amdgcn_mfma_f32_32x32x16_bf16(ka1,qaug,f32x16{},0,0,0);
  #pragma unroll
  for(int d0=0;d0<4;++d0){
    const bf16x8 b0=*reinterpret_cast<const bf16x8*>(kb+d0*2048);
    const bf16x8 b1=*reinterpret_cast<const bf16x8*>(kb+d0*2048+512);
    p0=__builtin_amdgcn_mfma_f32_32x32x16_bf16(b0,qr[d0],p0,0,0,0);p1=__builtin_amdgcn_mfma_f32_32x32x16_bf16(b1,qr[d0],p1,0,0,0);}
}
typedef __attribute__((address_space(3))) const char* lds_cptr;
typedef short v4i16_t __attribute__((ext_vector_type(4)));
__device__ __forceinline__ void kload8(bf16x8*kf,lds_cptr kp){
  kf[0]=*(const __attribute__((address_space(3))) bf16x8*)(kp);      kf[1]=*(const __attribute__((address_space(3))) bf16x8*)(kp+512);
  kf[2]=*(const __attribute__((address_space(3))) bf16x8*)(kp+2048); kf[3]=*(const __attribute__((address_space(3))) bf16x8*)(kp+2560);
  kf[4]=*(const __attribute__((address_space(3))) bf16x8*)(kp+4096); kf[5]=*(const __attribute__((address_space(3))) bf16x8*)(kp+4608);
  kf[6]=*(const __attribute__((address_space(3))) bf16x8*)(kp+6144); kf[7]=*(const __attribute__((address_space(3))) bf16x8*)(kp+6656);
}
__device__ __forceinline__ void kload2(bf16x8*kf,lds_cptr kp,int j){ kf[2*j]=*(const __attribute__((address_space(3))) bf16x8*)(kp+j*2048); kf[2*j+1]=*(const __attribute__((address_space(3))) bf16x8*)(kp+j*2048+512); }
__device__ __forceinline__ s16x4 vtr(lds_cptr p){ return __builtin_bit_cast(s16x4,__builtin_amdgcn_ds_read_tr16_b64_v4i16((__attribute__((address_space(3))) v4i16_t*)p)); }
__device__ __forceinline__ float rowmax(const f32x16&p0,const f32x16&p1){
  float a=max3f(p0[0],p0[1],p1[0]),b=max3f(p0[2],p0[3],p1[1]);a=max3f(a,p1[2],p1[3]);
  #pragma unroll
  for(int r=4;r<16;r+=4){a=max3f(a,p0[r],p0[r+1]);b=max3f(b,p0[r+2],p0[r+3]);a=max3f(a,p1[r],p1[r+1]);b=max3f(b,p1[r+2],p1[r+3]);}
  const float m=max2f(a,b);
  auto rr=__builtin_amdgcn_permlane32_swap(__float_as_uint(m),__float_as_uint(m),false,false);
  return max2f(__uint_as_float(rr[0]),__uint_as_float(rr[1]));
}
__device__ __forceinline__ void pv(f32x16*o,int vb,bf16x8 pa0,bf16x8 pa1,bf16x8 pa2,bf16x8 pa3){
  #pragma unroll
  for(int d0=0;d0<2;++d0){s16x4 lo[4],hi[4];
    #pragma unroll
    for(int ks=0;ks<4;++ks){
      asm volatile("ds_read_b64_tr_b16 %0,%1 offset:%c2":"=&v"(lo[ks]):"v"(vb),"i"(d0*4096+ks*1024):"memory");
      asm volatile("ds_read_b64_tr_b16 %0,%1 offset:%c2":"=&v"(hi[ks]):"v"(vb),"i"(d0*4096+ks*1024+512):"memory");}
    asm volatile("s_waitcnt lgkmcnt(0)":::"memory");SBAR();
    #define PK(k) (bf16x8){lo[k][0],lo[k][1],lo[k][2],lo[k][3],hi[k][0],hi[k][1],hi[k][2],hi[k][3]}
    o[d0]=__builtin_amdgcn_mfma_f32_32x32x16_bf16(pa0,PK(0),o[d0],0,0,0);
    o[d0]=__builtin_amdgcn_mfma_f32_32x32x16_bf16(pa1,PK(1),o[d0],0,0,0);
    o[d0]=__builtin_amdgcn_mfma_f32_32x32x16_bf16(pa2,PK(2),o[d0],0,0,0);
    o[d0]=__builtin_amdgcn_mfma_f32_32x32x16_bf16(pa3,PK(3),o[d0],0,0,0);
    #undef PK
  }
}

#ifndef ATTN_STORE16
#define ATTN_STORE16(p,v) (*(u32x4*)(p)=(v))
#endif
template<int THRL> __device__ __forceinline__ void attn_unit(int b,int h,int qb,const bf16*Q,const bf16*__restrict__ K,const bf16*__restrict__ V,bf16*O,char*shm,const char*kaug,const int tid,const int tstart){
  const int lane=tid&63,r32=lane&31,hi=lane>>5; const int wid=__builtin_amdgcn_readfirstlane(tid>>6);
  const long rowbase=(long)b*SEQ; const int q0=qb*QB;
  const bf16*Qw=Q+(rowbase+q0+wid*QBLK)*DM+h*D;
  const bf16*Kh=K+(rowbase+(long)tstart*KVBLK)*DM+h*D,*Vh=V+(rowbase+(long)tstart*KVBLK)*DM+h*D;
  const unsigned lds0=(unsigned)(uintptr_t)shm;
  float*wsf=(float*)(shm+LDS_WS)+wid*64;
  const float*wsfh=wsf+4*hi;
  const bf16*ksrc=Kh+(long)lane*DM+wid*8;
  const bf16*vsrc=Vh+(long)(16*(wid&3)+(lane>>2))*DM+(wid>>2)*32+(lane&3)*8;
  const unsigned kdst=lds0+LDS_K+wid*1024, vdst=lds0+LDS_V+wid*1024;
  #define DMA_K(t,slot) glds16(ksrc+(long)(t)*KVBLK*DM,(unsigned)__builtin_amdgcn_readfirstlane(kdst+(slot)))
  #define DMA_V(t,slot) glds16(vsrc+(long)(t)*KVBLK*DM,(unsigned)__builtin_amdgcn_readfirstlane(vdst+(slot)))
  const int vb0=(int)(lds0+LDS_V)+((lane>>4)&1)*32+(lane&3)*8+(4*hi+((lane&15)>>2))*64;
  const char*Kbase=shm+LDS_K; bf16x8 kf[8];
  const lds_cptr shm3=(lds_cptr)shm; const lds_cptr kp0=shm3+LDS_K+hi*1024+r32*16; const lds_cptr vp0=shm3+LDS_V+((lane>>4)&1)*32+(lane&3)*8+(4*hi+((lane&15)>>2))*64;
  const int NT=(q0+QB)/KVBLK-tstart;
  kaug+=8*KVBLK*tstart;
  DMA_K(0,0);DMA_V(0,0);DMA_K(1,SLOTB);
  bf16x8 qr[4];
  #pragma unroll
  for(int d0=0;d0<4;++d0)qr[d0]=*reinterpret_cast<const bf16x8*>(&Qw[(long)r32*DM+d0*16+hi*8]);
  float mhat=0.f,l_reg=0.f;f32x16 o[2];o[0]=f32x16{};o[1]=f32x16{};
  const int qrel=wid*QBLK+r32;
  #define CMASK(P0,P1,t) do{int jb_=(t)-(NT-4); if(jb_>=0)cmask(P0,P1,jb_,qrel,hi);}while(0)
  #define KAUG(t,kb_) ({ const u32x2 rc_=*(const u32x2*)(kaug+(KVBLK*(t)+32*(kb_)+r32)*8); u32x4 w_; w_.x=hi?0u:rc_.x; w_.y=hi?0u:((rc_.y&0xffffu)|0xBF800000u); w_.z=hi?0u:0xBF80BF80u; w_.w=0u; __builtin_bit_cast(bf16x8,w_); })
  bf16x8 qaug;
  #define QAUG() do{ const unsigned ph_=cvtpk_s(mhat,0.f)&0xffffu; const float r1_=mhat-__uint_as_float(ph_<<16); const unsigned pm_=cvtpk_s(r1_,0.f)&0xffffu; const float r2_=r1_-__uint_as_float(pm_<<16); \
      const unsigned pl_=cvtpk_s(r2_,0.f)&0xffffu; u32x4 w_; w_.x=hi?0u:0x3F803F80u; w_.y=hi?0u:(0x3F80u|(ph_<<16)); w_.z=hi?0u:(pm_|(pl_<<16)); w_.w=0u; qaug=__builtin_bit_cast(bf16x8,w_); }while(0)
  bool resc=false;
  #define START(P0,P1) do{ const float rm=rowmax(P0,P1); resc=false; \
    { const float dl=rm; mhat=fadd_s(mhat,dl); QAUG(); \
      _Pragma("unroll") for(int r=0;r<16;++r){P0[r]=fsub_s(P0[r],dl);P1[r]=fsub_s(P1[r],dl);} \
      } \
    _Pragma("unroll") for(int r=0;r<16;++r)P0[r]=__builtin_amdgcn_exp2f(P0[r]); }while(0)
  #define RESC() do{ if(resc){ asm volatile("s_waitcnt lgkmcnt(0)":::"memory"); \
      _Pragma("unroll") for(int d_=0;d_<2;++d_) _Pragma("unroll") for(int r=0;r<16;++r)o[d_][r]*=wsfh[(r&3)+8*(r>>2)]; } }while(0)
  f32x16 pA0,pA1,pB0,pB1;
  int sl_prev=0,sl_cur=0,sl_next=SLOTB;
  #define ROT() do{sl_prev=sl_cur;sl_cur=sl_next;sl_next=(sl_next==(NSLOT-1)*SLOTB)?0:sl_next+SLOTB;}while(0)
  DMA_K(2,2*SLOTB);
  WAIT_BAR(3);
  QAUG(); qkt(pA0,pA1,Kbase,qr,r32,hi,KAUG(0,0),KAUG(0,1),qaug);asm volatile("s_nop 15\n\ts_nop 7":"+v"(pA0),"+v"(pA1));CMASK(pA0,pA1,0);
  START(pA0,pA1);
  _Pragma("unroll") for(int r=0;r<16;++r)pA1[r]=__builtin_amdgcn_exp2f(pA1[r]);
  WAIT_BAR(0);
  DMA_K(3,0);DMA_V(1,SLOTB);
  ROT();
  kload8(kf,kp0+sl_cur);
  WAIT_BAR(2);
  s16x4 vlo[8],vhi[8]; u32x4 pw0,pw1,pw2,pw3;
  #define PKW(P,B) cvtpk_s(P[B],P[B+1])
  #define PAF(k) __builtin_bit_cast(bf16x8,pw##k)
  #define VFR(i) (bf16x8){vlo[i][0],vlo[i][1],vlo[i][2],vlo[i][3],vhi[i][0],vhi[i][1],vhi[i][2],vhi[i][3]}
  #define PIN(x) asm volatile("":"+v"(x))
  #define MX3(a,b,c) __builtin_fmaxf(__builtin_fmaxf((a),(b)),(c))
  #define GAPA(MF,A0,A1,A2,A3,W0,W1,PW) do{ MF; sacc+=A0; sacc+=A1; sacc+=A2; sacc+=A3; PIN(sacc); W0; W1; PIN(PW); SBAR(); }while(0)
  #define EX(v) __builtin_amdgcn_exp2f(v)
  #define GAPB(MF,X,B) do{ MF; X[B]=EX(X[B]); X[B+1]=EX(X[B+1]); X[B+2]=EX(X[B+2]); X[B+3]=EX(X[B+3]); PIN(X); SBAR(); }while(0)
  #define VRD(i) do{ vlo[i]=vtr(vp_+(((i)>>2)*4096+((i)&3)*1024)); vhi[i]=vtr(vp_+(((i)>>2)*4096+((i)&3)*1024+512)); }while(0)
  #define KRD(G,j) do{ if(G){ kload2(kf,kp0+sl_next,j); SBAR(); } }while(0)
  #define STEP(C0,C1,P0,P1,t,GK,GV,GL) do{ SBAR(); \
    const lds_cptr vp_=vp0+sl_prev; \
    { const bf16x8 ka0_=KAUG(t,0), ka1_=KAUG(t,1); C0=__builtin_amdgcn_mfma_f32_32x32x16_bf16(ka0_,qaug,f32x16{},0,0,0); C1=__builtin_amdgcn_mfma_f32_32x32x16_bf16(ka1_,qaug,f32x16{},0,0,0); SBAR(); } \
    VRD(0); SBAR(); float sacc=(P0[0]+P0[1]); \
    GAPA(C0=__builtin_amdgcn_mfma_f32_32x32x16_bf16(kf[0],qr[0],C0,0,0,0), P0[2],P0[3],P0[4],P0[5],     pw0[0]=PKW(P0,0), pw0[1]=PKW(P0,2), pw0); \
    VRD(4); SBAR(); GAPA(C1=__builtin_amdgcn_mfma_f32_32x32x16_bf16(kf[1],qr[0],C1,0,0,0), P0[6],P0[7],P0[8],P0[9],     pw0[2]=PKW(P0,4), pw0[3]=PKW(P0,6), pw0); \
    VRD(1); SBAR(); GAPA(C0=__builtin_amdgcn_mfma_f32_32x32x16_bf16(kf[2],qr[1],C0,0,0,0),   P0[10],P0[11],P0[12],P0[13], pw1[0]=PKW(P0,8), pw1[1]=PKW(P0,10), pw1); \
    VRD(5); SBAR(); GAPA(C1=__builtin_amdgcn_mfma_f32_32x32x16_bf16(kf[3],qr[1],C1,0,0,0),   P0[14],P0[15],P1[0],P1[1],   pw1[2]=PKW(P0,12),pw1[3]=PKW(P0,14), pw1); \
    VRD(2); SBAR(); GAPA(C0=__builtin_amdgcn_mfma_f32_32x32x16_bf16(kf[4],qr[2],C0,0,0,0),   P1[2],P1[3],P1[4],P1[5],     pw2[0]=PKW(P1,0), pw2[1]=PKW(P1,2), pw2); \
    VRD(6); SBAR(); GAPA(C1=__builtin_amdgcn_mfma_f32_32x32x16_bf16(kf[5],qr[2],C1,0,0,0),   P1[6],P1[7],P1[8],P1[9],     pw2[2]=PKW(P1,4), pw2[3]=PKW(P1,6), pw2); \
    VRD(3); SBAR(); GAPA(C0=__builtin_amdgcn_mfma_f32_32x32x16_bf16(kf[6],qr[3],C0,0,0,0),   P1[10],P1[11],P1[12],P1[13], pw3[0]=PKW(P1,8), pw3[1]=PKW(P1,10), pw3); \
    VRD(7); SBAR(); GAPA(C1=__builtin_amdgcn_mfma_f32_32x32x16_bf16(kf[7],qr[3],C1,0,0,0),   P1[14],P1[15],0.f,0.f,       pw3[2]=PKW(P1,12),pw3[3]=PKW(P1,14), pw3); \
    l_reg+=sacc; \
    if(GK){DMA_K((t)+3,sl_cur);} if(GV){DMA_V((t)+1,sl_next);} \
    CMASK(C0,C1,t); \
    { float a=MX3(C0[0],C0[1],C1[0]),b=MX3(C0[2],C0[3],C1[1]); a=MX3(a,C1[2],C1[3]); \
      _Pragma("unroll") for(int r=4;r<16;r+=4){a=MX3(a,C0[r],C0[r+1]);b=MX3(b,C0[r+2],C0[r+3]);a=MX3(a,C1[r],C1[r+1]);b=MX3(b,C1[r+2],C1[r+3]);} \
      float rm=__builtin_fmaxf(a,b); { auto rr=__builtin_amdgcn_permlane32_swap(__float_as_uint(rm),__float_as_uint(rm),false,false); rm=__builtin_fmaxf(__uint_as_float(rr[0]),__uint_as_float(rr[1])); } \
      resc=false; \
      if(__builtin_expect(__any(rm>(float)THRL),0)){ const float dl=__builtin_fmaxf(rm,0.f); mhat+=dl; QAUG(); \
        _Pragma("unroll") for(int r=0;r<16;++r){C0[r]-=dl;C1[r]-=dl;} \
        const float f=__builtin_amdgcn_exp2f(-dl); l_reg*=f; if(hi==0)wsf[r32]=f; resc=true; } } \
    SBAR(); \
    GAPB(o[0]=__builtin_amdgcn_mfma_f32_32x32x16_bf16(PAF(0),VFR(0),o[0],0,0,0), C0,0); \
    GAPB(o[1]=__builtin_amdgcn_mfma_f32_32x32x16_bf16(PAF(0),VFR(4),o[1],0,0,0), C0,4); \
    KRD(GL,0); GAPB(o[0]=__builtin_amdgcn_mfma_f32_32x32x16_bf16(PAF(1),VFR(1),o[0],0,0,0), C0,8); \
    KRD(GL,1); GAPB(o[1]=__builtin_amdgcn_mfma_f32_32x32x16_bf16(PAF(1),VFR(5),o[1],0,0,0), C0,12); \
    KRD(GL,2); GAPB(o[0]=__builtin_amdgcn_mfma_f32_32x32x16_bf16(PAF(2),VFR(2),o[0],0,0,0), C1,0); \
    KRD(GL,3); GAPB(o[1]=__builtin_amdgcn_mfma_f32_32x32x16_bf16(PAF(2),VFR(6),o[1],0,0,0), C1,4); \
    GAPB(o[0]=__builtin_amdgcn_mfma_f32_32x32x16_bf16(PAF(3),VFR(3),o[0],0,0,0), C1,8); \
    GAPB(o[1]=__builtin_amdgcn_mfma_f32_32x32x16_bf16(PAF(3),VFR(7),o[1],0,0,0), C1,12); \
    }while(0)
  int t=1;
  #undef CMASK
  #define CMASK(P0,P1,t) do{}while(0)
  for(;t+5<NT;t+=2){
    STEP(pB0,pB1,pA0,pA1,t,true,true,true);     WAIT_BAR(2); RESC(); ROT();
    STEP(pA0,pA1,pB0,pB1,t+1,true,true,true);   WAIT_BAR(2); RESC(); ROT();
  }
  #undef CMASK
  #define CMASK(P0,P1,t) do{int jb_=(t)-(NT-4); if(jb_>=0)cmask(P0,P1,jb_,qrel,hi);}while(0)
  #define ENDW(tt) do{ if((tt)+3<NT){WAIT_BAR(2);} else if((tt)+2<NT){WAIT_BAR(1);} else {WAIT_BAR(0);} }while(0)
  for(;t+1<NT;t+=2){
    STEP(pB0,pB1,pA0,pA1,t,(t+3<NT),(t+1<NT),(t+1<NT));       ENDW(t);   RESC(); ROT();
    STEP(pA0,pA1,pB0,pB1,t+1,(t+4<NT),(t+2<NT),(t+2<NT));     ENDW(t+1); RESC(); ROT();
  }
  STEP(pB0,pB1,pA0,pA1,NT-1,false,false,false); RESC();
  { float sacc=pB0[0]+pB0[1]; _Pragma("unroll") for(int r=2;r<16;++r)sacc+=pB0[r]; _Pragma("unroll") for(int r=0;r<16;++r)sacc+=pB1[r]; l_reg+=sacc;
    pw0=(u32x4){PKW(pB0,0),PKW(pB0,2),PKW(pB0,4),PKW(pB0,6)};pw1=(u32x4){PKW(pB0,8),PKW(pB0,10),PKW(pB0,12),PKW(pB0,14)};pw2=(u32x4){PKW(pB1,0),PKW(pB1,2),PKW(pB1,4),PKW(pB1,6)};pw3=(u32x4){PKW(pB1,8),PKW(pB1,10),PKW(pB1,12),PKW(pB1,14)};
    SBAR(); pv(o,vb0+sl_cur,PAF(0),PAF(1),PAF(2),PAF(3)); }
  #undef PKW
  #undef PAF
  #undef VFR
  #undef PIN
  #undef MX3
  #undef GAPA
  #undef GAPB
  #undef EX
  #undef VRD
  #undef KRD
  #undef STEP
  #undef ENDW
  {auto rr=__builtin_amdgcn_permlane32_swap(__float_as_uint(l_reg),__float_as_uint(l_reg),false,false);l_reg=__uint_as_float(rr[0])+__uint_as_float(rr[1]);}
  if(hi==0)wsf[32+r32]=l_reg;asm volatile("s_waitcnt lgkmcnt(0)":::"memory");
  float rli[16];
  #pragma unroll
  for(int r=0;r<16;++r)rli[r]=__builtin_amdgcn_rcpf(wsfh[32+(r&3)+8*(r>>2)]);
  bf16*Ow=O+(rowbase+q0+wid*QBLK)*DMO+h*D;
  { bf16*stg=(bf16*)(shm+LDS_OST)+wid*2048;
    bf16*stgh=stg+4*hi*64+r32;
    #pragma unroll
    for(int r=0;r<16;++r){
      #pragma unroll
      for(int d0=0;d0<2;++d0)stgh[((r&3)+8*(r>>2))*64+d0*32]=__float2bfloat16(o[d0][r]*rli[r]);}
    asm volatile("s_waitcnt lgkmcnt(0)":::"memory");
    #pragma unroll
    for(int i=0;i<4;++i){const int row=i*8+(lane>>3),ch=lane&7; const u32x4 v=*(const u32x4*)(stg+row*64+ch*8); ATTN_STORE16(Ow+(long)row*DMO+ch*8,v);} }
  asm volatile("s_waitcnt lgkmcnt(0)\n\ts_barrier":::"memory");
  #undef DMA_K
  #undef DMA_V
  #undef CMASK
  #undef KAUG
  #undef QAUG
  #undef START
  #undef RESC
  #undef ROT
}
constexpr int ATTN_LDS_BYTES=LDS_BYTES;
#undef SBAR
#undef WAIT_BAR
}

struct Frame {
    CParams* p; unsigned char* ws; LAS unsigned char* lds; int tid, lane, wid, G, bid;
    __device__ __forceinline__ Frame fresh() const { Frame G2 = *this; int t, w = wid; asm volatile("v_mbcnt_lo_u32_b32 %0, -1, 0\n\tv_mbcnt_hi_u32_b32 %0, -1, %0\n\tv_lshl_add_u32 %0, %1, 6, %0" : "=&v"(t), "+s"(w)); G2.tid = t; G2.lane = t & 63; G2.wid = w; return G2; }
    __device__ __forceinline__ bf16_t* hb() const { return (bf16_t*)(ws + WS_HB); }
    __device__ __forceinline__ bf16_t* x0() const { return (bf16_t*)p->out; }
    __device__ __forceinline__ bf16_t* ybuf() const { return (bf16_t*)p->out + (size_t)T * D; }
    __device__ __forceinline__ bf16_t* r1() const { return (bf16_t*)(ws + WS_R1); }
    __device__ __forceinline__ bf16_t* r2() const { return (bf16_t*)(ws + WS_R2); }
    __device__ __forceinline__ bf16_t* r3() const { return (bf16_t*)(ws + WS_R3); }
    __device__ __forceinline__ bf16_t* wt(size_t eoff) const { return (bf16_t*)(ws + WS_W) + eoff; }
    __device__ __forceinline__ float* smf(size_t boff) const { return (float*)(ws + WS_SM + boff); }
    __device__ __forceinline__ int* smi(size_t boff) const { return (int*)(ws + WS_SM + boff); }
};

struct CvtJob { const float* src; const float* src2; const float* gain; bf16_t* dst; int ld, mode, K, N, tile; };
constexpr int CV_A = 64 * 192, CV_B = 4 * 320, CV_C = 2 * 1680, CV_TOTAL = CV_A + CV_B + CV_C;
__device__ __forceinline__ void cvt_decode(const Frame& F, int g, CvtJob& J) {
    CParams& p = *F.p;
    J.src2 = nullptr; J.gain = nullptr; J.mode = 0;
    if (g < CV_A) { const int ie = g / 192, r = g % 192, i = ie >> 4;
        if (r < 128) { J.src = p.in[20] + (size_t)ie * D * DEXP; J.src2 = p.in[21] + (size_t)ie * D * DEXP; J.ld = DEXP; J.mode = 2; J.dst = F.wt(WL_UP + (size_t)ie * 512 * D); J.K = D; J.N = 512; J.gain = p.in[3] + i * D; J.tile = r; }
        else { J.src = p.in[22] + (size_t)ie * DEXP * D; J.ld = D; J.dst = F.wt(WL_DN + (size_t)ie * D * DEXP); J.K = DEXP; J.N = D; J.tile = r - 128; }
        return; }
    g -= CV_A;
    if (g < CV_B) { const int i = g / 320, r = g % 320;
        if (r < 64) { J.src = p.in[23] + (size_t)i * PLE * D; J.ld = D; J.dst = F.wt(WL_PP + (size_t)i * D * PLE); J.K = PLE; J.N = D; J.tile = r; }
        else { J.src = p.in[25] + (size_t)i * D * D; J.ld = D; J.dst = F.wt(WL_PG + (size_t)i * D * D); J.K = D; J.N = D; J.tile = r - 64; }
        return; }
    g -= CV_B;
    { const int j = g / 1680, r = g % 1680;
      if (r < 640) { J.src = p.in[4] + (size_t)j * D * EVEN_IN; J.ld = EVEN_IN; J.dst = F.wt(WE_IN + (size_t)j * EVEN_IN * D); J.K = D; J.N = EVEN_IN; J.gain = p.in[2] + (2 * j) * D; J.tile = r; }
      else if (r < 896) { J.src = p.in[8] + (size_t)j * D * D; J.ld = D; J.dst = F.wt(WE_OUT + (size_t)j * D * D); J.K = D; J.N = D; J.tile = r - 640; }
      else if (r < 1408) { J.src = p.in[9] + (size_t)j * D * ODD_IN; J.ld = ODD_IN; J.mode = 1; J.dst = F.wt(WO_IN + (size_t)j * ODD_N * D); J.K = D; J.N = ODD_N; J.gain = p.in[2] + (2 * j + 1) * D; J.tile = r - 896; }
      else if (r < 1664) { J.src = p.in[15] + (size_t)j * D * D; J.ld = D; J.dst = F.wt(WO_OUT + (size_t)j * D * D); J.K = D; J.N = D; J.tile = r - 1408; }
      else { const int gq = (r - 1664) >> 2; J.src = p.in[13] + ((size_t)j * 4 + gq) * 128 * 128; J.ld = 128; J.dst = F.wt(WO_POOL + ((size_t)j * 4 + gq) * 128 * 128); J.K = 128; J.N = 128; J.tile = (r - 1664) & 3; } }
}
__device__ __forceinline__ void p0_prologue(const Frame& F) {
    CParams& p = *F.p;
    { const float* x = p.in[0]; bf16_t* hb = F.x0(); float* ss = F.smf(SM_SSA);
      for (int row = F.bid * 8 + F.wid; row < T; row += F.G * 8) {
          float q = 0.f;
#pragma unroll
          for (int hf = 0; hf < 2; ++hf) { const size_t off = (size_t)row * D + hf * 512 + F.lane * 8;
              const f32x4 a = *(const f32x4*)(x + off), b = *(const f32x4*)(x + off + 4);
              u32x4 w; w.x = cvt_pk_bf16(a[0], a[1]); w.y = cvt_pk_bf16(a[2], a[3]); w.z = cvt_pk_bf16(b[0], b[1]); w.w = cvt_pk_bf16(b[2], b[3]);
              *(u32x4*)(hb + off) = w;
              q += (a[0] * a[0] + a[1] * a[1]) + (a[2] * a[2] + a[3] * a[3]) + (b[0] * b[0] + b[1] * b[1]) + (b[2] * b[2] + b[3] * b[3]); }
          q = wave_sum(q);
          if (F.lane < 16) ss[(size_t)row * 16 + F.lane] = F.lane == 0 ? q : 0.f; } }
    { LAS float* tile = (LAS float*)F.lds;
#pragma unroll 1
      for (int g = F.bid; g < CV_TOTAL; g += F.G) {
        CvtJob J; cvt_decode(F, g, J);
        const int tn = J.N >> 6; const int n0 = (J.tile % tn) * 64, k0 = (J.tile / tn) * 64;
        { const int kk = F.tid >> 3, nn = (F.tid & 7) * 8; const int n = n0 + nn; const float* sp = J.src; int col = n;
          if (J.mode == 1) col = n < 1536 ? n : n + 8;
          if (J.mode == 2) { const int pn = n >> 8, half = (n >> 7) & 1, c = n & 127; sp = half ? J.src2 : J.src; col = pn * 128 + c; }
          const float gn = J.gain ? J.gain[k0 + kk] : 1.0f;
          const f32x4 a = *(const f32x4*)(sp + (size_t)(k0 + kk) * J.ld + col), b = *(const f32x4*)(sp + (size_t)(k0 + kk) * J.ld + col + 4);
#pragma unroll
          for (int q = 0; q < 4; ++q) { tile[kk * 65 + nn + q] = a[q] * gn; tile[kk * 65 + nn + 4 + q] = b[q] * gn; } }
        __syncthreads();
        { const int nn = F.tid >> 3, kc = (F.tid & 7) * 8; float v[8];
#pragma unroll
          for (int q = 0; q < 8; ++q) v[q] = tile[(kc + q) * 65 + nn];
          u32x4 w; w.x = cvt_pk_bf16(v[0], v[1]); w.y = cvt_pk_bf16(v[2], v[3]); w.z = cvt_pk_bf16(v[4], v[5]); w.w = cvt_pk_bf16(v[6], v[7]);
          *(u32x4*)(J.dst + (size_t)(n0 + nn) * J.K + k0 + kc) = w; }
        __syncthreads();
      } }
    { const float* s = p.in[5]; bf16_t* d = F.wt(WE_SGU);
      for (int i = F.bid * NTHREADS + F.tid; i < 2 * 8 * 128 * 128 / 8; i += F.G * NTHREADS) {
          const int e0 = i * 8, tt = (e0 >> 7) & 127, s0 = e0 & 127; float v[8];
          const f32x4 a = *(const f32x4*)(s + e0), b = *(const f32x4*)(s + e0 + 4);
#pragma unroll
          for (int j = 0; j < 4; ++j) { v[j] = (s0 + j <= tt) ? a[j] : 0.f; v[4 + j] = (s0 + 4 + j <= tt) ? b[j] : 0.f; }
          u32x4 w; w.x = cvt_pk_bf16(v[0], v[1]); w.y = cvt_pk_bf16(v[2], v[3]); w.z = cvt_pk_bf16(v[4], v[5]); w.w = cvt_pk_bf16(v[6], v[7]);
          *(u32x4*)(d + e0) = w; } }
    for (int i = F.bid * NTHREADS + F.tid; i < 2 * 16 * D; i += F.G * NTHREADS) {
        const int j = i / (16 * D), h = (i / D) & 15, k = i % D;
        const float w = h < 8 ? p.in[2][(2 * j + 1) * D + k] * p.in[9][((size_t)j * D + k) * ODD_IN + 1536 + h] : 0.f;
        const unsigned hi = cvt_pk_bf16(w, 0.f) & 0xffffu; const unsigned lo = cvt_pk_bf16(w - bf_lo(hi), 0.f) & 0xffffu;
        bf16_t* wb = (bf16_t*)(F.ws + WS_SM + SM_WFB) + (size_t)j * 2 * 16 * D;
        wb[h * D + k] = (bf16_t)hi; wb[16 * D + h * D + k] = (bf16_t)lo; }
    for (int i = F.bid * NTHREADS + F.tid; i < 4 * 32 * D; i += F.G * NTHREADS) {
        const int l = i / (32 * D), o = (i / D) & 31, k = i % D;
        float w = 0.f;
        if (o < 4) w = p.in[16][((size_t)l * D + k) * 4 + o]; else if (o < 20) w = p.in[18][((size_t)l * D + k) * 16 + (o - 4)];
        w *= p.in[3][l * D + k];
        const unsigned hi = cvt_pk_bf16(w, 0.f) & 0xffffu; const unsigned lo = cvt_pk_bf16(w - bf_lo(hi), 0.f) & 0xffffu;
        bf16_t* rb = (bf16_t*)(F.ws + WS_SM + SM_RWB) + (size_t)l * 2 * 32 * D;
        rb[o * D + k] = (bf16_t)hi; rb[32 * D + o * D + k] = (bf16_t)lo; }
}

__device__ __forceinline__ void logf_units(const Frame& F, int j) {
    CParams& p = *F.p;
    constexpr int WP = 1032;
    LAS unsigned char* wls = F.lds;
    const bf16_t* wfb = (const bf16_t*)(F.ws + WS_SM + SM_WFB) + (size_t)j * 2 * 16 * D;
    __syncthreads();
    for (int i = F.tid; i < 2 * 8 * 128; i += NTHREADS) { const int hl = i / (8 * 128), o = (i / 128) & 7, c = i & 127;
        *(LAS u32x4*)(wls + ((hl * 8 + o) * WP + c * 8) * 2) = *(const u32x4*)(wfb + (size_t)hl * 16 * D + (size_t)o * D + c * 8); }
    __syncthreads();
    const bf16_t* hb = F.x0(); const float* ss = F.smf(SM_SSA); float* lf = F.smf(SM_LOGF);
    const int l15 = F.lane & 15, lq = F.lane >> 4;
    const bool zr = l15 >= 8; const int o = zr ? 0 : l15;
    const LAS unsigned char* wh = wls + (o * WP + 8 * lq) * 2; const LAS unsigned char* wl = wh + 8 * WP * 2;
    for (int blk = F.bid; blk < T / 128; blk += F.G) {
        const int row0 = blk * 128 + F.wid * 16;
        const bf16_t* xp = hb + (size_t)(row0 + l15) * D + 8 * lq;
        f32x4 acc = (f32x4){0.f, 0.f, 0.f, 0.f};
#pragma unroll 8
        for (int ks = 0; ks < 32; ++ks) {
            const bf16x8 ah = *(const bf16x8*)(xp + ks * 32);
            bf16x8 bh = *(const LAS bf16x8*)(wh + ks * 64), bl = *(const LAS bf16x8*)(wl + ks * 64);
            if (zr) { bh = (bf16x8){0, 0, 0, 0, 0, 0, 0, 0}; bl = bh; }
            acc = __builtin_amdgcn_mfma_f32_16x16x32_bf16(ah, bh, acc, 0, 0, 0); acc = __builtin_amdgcn_mfma_f32_16x16x32_bf16(ah, bl, acc, 0, 0, 0); }
        if (l15 < 8) {
            const float fb = p.in[10][j * 8 + l15];
#pragma unroll
            for (int e = 0; e < 4; ++e) { const int row = row0 + 4 * lq + e;
                const float xx = acc[e] * rstd_from16(ss + (size_t)row * 16) + fb;
                lf[((size_t)(row >> 12) * 8 + l15) * SEQ + (row & (SEQ - 1))] = fminf(xx, 0.f) - 0.6931471806f * __builtin_amdgcn_logf(1.0f + fast_exp2(-LOG2E * fabsf(xx))); } }
    }
    __syncthreads();
}

constexpr int AT_KP = 72;

__device__ __forceinline__ void sb_wave_unit(const Frame& F, const bf16_t* Q, const bf16_t* Kg, const bf16_t* Vg, int ld, bf16_t* O, int ldo, int b, int h, int qblk) {
    const int lane = F.lane, r32 = lane & 31, hh = lane >> 5;
    LAS unsigned char* vl = F.lds + F.wid * (64 * AT_KP * 2);
    const int trb = ((((lane & 15) >> 2) + 4 * hh) * AT_KP + ((lane >> 4) & 1) * 16 + (lane & 3) * 4) * 2;
    const int qw0 = qblk * 32; const size_t rowbase = (size_t)b * SEQ;
    bf16x8 qf[4];
#pragma unroll
    for (int s = 0; s < 4; ++s) qf[s] = *(const bf16x8*)(Q + (rowbase + qw0 + r32) * ld + h * 64 + s * 16 + hh * 8);
    f32x16 o0, o1;
#pragma unroll
    for (int i = 0; i < 16; ++i) { o0[i] = 0.f; o1[i] = 0.f; }
    float R = 1.0f;
    const int kt0 = (qw0 + 30) >> 6;
    const bf16_t* kbase = Kg + rowbase * ld + h * 64 + (lane & 7) * 8;
    const bf16_t* vbase = Vg + rowbase * ld + h * 64 + (lane & 7) * 8;
    u32x4 kr[8], vr[8];
#pragma unroll
    for (int i = 0; i < 8; ++i) { kr[i] = *(const u32x4*)(kbase + (size_t)(kt0 * 64 + i * 8 + (lane >> 3)) * ld); vr[i] = *(const u32x4*)(vbase + (size_t)(kt0 * 64 + i * 8 + (lane >> 3)) * ld); }
#pragma unroll 1
    for (int kt = kt0; kt >= 0; --kt) {
        bf16x8 kf[2][4];
#pragma unroll
        for (int i = 0; i < 8; ++i) *(LAS u32x4*)(vl + ((i * 8 + (lane >> 3)) * AT_KP + (lane & 7) * 8) * 2) = kr[i];
#pragma unroll
        for (int kb = 0; kb < 2; ++kb)
#pragma unroll
            for (int s = 0; s < 4; ++s) kf[kb][s] = *(const LAS bf16x8*)(vl + ((kb * 32 + r32) * AT_KP + s * 16 + hh * 8) * 2);
#pragma unroll
        for (int i = 0; i < 8; ++i) *(LAS u32x4*)(vl + ((i * 8 + (lane >> 3)) * AT_KP + (lane & 7) * 8) * 2) = vr[i];
        if (kt > 0) {
#pragma unroll
            for (int i = 0; i < 8; ++i) { kr[i] = *(const u32x4*)(kbase + (size_t)((kt - 1) * 64 + i * 8 + (lane >> 3)) * ld); vr[i] = *(const u32x4*)(vbase + (size_t)((kt - 1) * 64 + i * 8 + (lane >> 3)) * ld); } }
        f32x16 s0, s1;
#pragma unroll
        for (int i = 0; i < 16; ++i) { s0[i] = 0.f; s1[i] = 0.f; }
#pragma unroll
        for (int s = 0; s < 4; ++s) { s0 = MFMA32(kf[0][s], qf[s], s0); s1 = MFMA32(kf[1][s], qf[s], s1); }
        const int lim = (qw0 + r32) - (kt * 64 + 4 * hh);
        const bool diag = kt * 64 + 63 >= qw0;
        float gp0[4], gp1[4];
#pragma unroll
        for (int a = 0; a < 4; ++a) {
            float be0[4], om0[4], be1[4], om1[4];
#pragma unroll
            for (int e = 0; e < 4; ++e) {
                { const float ex = fast_exp2(-fmaxf(s0[4 * a + e], -126.f)), r = fast_rcp(1.0f + ex);
                  const bool msk = diag && (8 * a + e) >= lim; be0[e] = msk ? 0.f : r; om0[e] = msk ? 1.f : ex * r; }
                { const float ex = fast_exp2(-fmaxf(s1[4 * a + e], -126.f)), r = fast_rcp(1.0f + ex);
                  const bool msk = diag && (8 * a + e + 32) >= lim; be1[e] = msk ? 0.f : r; om1[e] = msk ? 1.f : ex * r; } }
            { const float c2 = om0[3], c1 = c2 * om0[2], c0 = c1 * om0[1]; gp0[a] = c0 * om0[0];
              s0[4 * a + 3] = be0[3]; s0[4 * a + 2] = be0[2] * c2; s0[4 * a + 1] = be0[1] * c1; s0[4 * a] = be0[0] * c0; }
            { const float c2 = om1[3], c1 = c2 * om1[2], c0 = c1 * om1[1]; gp1[a] = c0 * om1[0];
              s1[4 * a + 3] = be1[3]; s1[4 * a + 2] = be1[2] * c2; s1[4 * a + 1] = be1[1] * c1; s1[4 * a] = be1[0] * c0; } }
        float pp0[4], pp1[4];
#pragma unroll
        for (int a = 0; a < 4; ++a) { pp0[a] = other_x32(gp0[a], hh); pp1[a] = other_x32(gp1[a], hh); }
        float S0[4], S1[4]; float t0 = 1.0f, t1 = 1.0f;
#pragma unroll
        for (int a = 3; a >= 0; --a) { S0[a] = t0 * (hh == 0 ? pp0[a] : 1.0f); S1[a] = t1 * (hh == 0 ? pp1[a] : 1.0f); t0 *= gp0[a] * pp0[a]; t1 *= gp1[a] * pp1[a]; }
        const float R1 = R, R0 = R * t1;
#pragma unroll
        for (int a = 0; a < 4; ++a)
#pragma unroll
            for (int e = 0; e < 4; ++e) { s1[4 * a + e] *= R1 * S1[a]; s0[4 * a + e] *= R0 * S0[a]; }
        R = R0 * t0;
#pragma unroll
        for (int kb = 0; kb < 2; ++kb)
#pragma unroll
            for (int j = 0; j < 2; ++j) {
                const f32x16& sv = kb ? s1 : s0;
                u32x4 pw; pw.x = cvt_pk_bf16(sv[8 * j], sv[8 * j + 1]); pw.y = cvt_pk_bf16(sv[8 * j + 2], sv[8 * j + 3]); pw.z = cvt_pk_bf16(sv[8 * j + 4], sv[8 * j + 5]); pw.w = cvt_pk_bf16(sv[8 * j + 6], sv[8 * j + 7]);
                const bf16x8 pb = __builtin_bit_cast(bf16x8, pw);
                const int kb16 = ((32 * kb + 16 * j) * AT_KP) * 2;
                { const s16x4 lo = tr_read(vl + kb16 + trb), hi = tr_read(vl + kb16 + trb + 8 * AT_KP * 2);
                  o0 = MFMA32(((bf16x8){lo[0], lo[1], lo[2], lo[3], hi[0], hi[1], hi[2], hi[3]}), pb, o0); }
                { const s16x4 lo = tr_read(vl + kb16 + trb + 64), hi = tr_read(vl + kb16 + trb + 8 * AT_KP * 2 + 64);
                  o1 = MFMA32(((bf16x8){lo[0], lo[1], lo[2], lo[3], hi[0], hi[1], hi[2], hi[3]}), pb, o1); }
            }
        if (__all(R < 1e-37f)) break;
    }
    bf16_t* orow = O + (rowbase + qw0 + r32) * ldo + h * 64;
#pragma unroll
    for (int a = 0; a < 4; ++a) {
        u32x2 w0, w1;
        w0.x = cvt_pk_bf16(o0[4 * a], o0[4 * a + 1]); w0.y = cvt_pk_bf16(o0[4 * a + 2], o0[4 * a + 3]);
        w1.x = cvt_pk_bf16(o1[4 * a], o1[4 * a + 1]); w1.y = cvt_pk_bf16(o1[4 * a + 2], o1[4 * a + 3]);
        *(u32x2*)(orow + 8 * a + 4 * hh) = w0; *(u32x2*)(orow + 32 + 8 * a + 4 * hh) = w1; }
}

constexpr int SG_P = 136;
__device__ __forceinline__ void sgu_unit(const Frame& F, int j, int unit) {
    CParams& p = *F.p;
    const bf16_t* proj = F.r1(); bf16_t* y = F.ybuf();
    const int r0 = unit * 128, lane = F.lane, r32 = lane & 31, hh = lane >> 5, tb = F.wid & 3, db = F.wid >> 2;
    LAS unsigned char* vl = F.lds;
    const int ls = F.tid >> 2, ld0 = (F.tid & 3) * 16;
    const int trb = ((((lane & 15) >> 2) + 8 * hh) * AT_KP + 32 * db + ((lane >> 4) & 1) * 16 + (lane & 3) * 4) * 2;
    const bf16_t* vsrc = proj + (size_t)(r0 + ls) * EVEN_IN + 512 + ld0;
    u32x4 va = *(const u32x4*)vsrc, vb = *(const u32x4*)(vsrc + 8);
    const int t = 32 * tb + r32, nks = 2 * tb + 2;
    bf16x8 bfr[8]; u32x2 uw[4]; float bs;
    { const bf16_t* W = F.wt(WE_SGU) + (size_t)j * 8 * 128 * 128;
#pragma unroll
      for (int ks = 0; ks < 8; ++ks) if (ks < nks) bfr[ks] = *(const bf16x8*)(W + (size_t)t * 128 + ks * 16 + hh * 8);
#pragma unroll
      for (int a = 0; a < 4; ++a) uw[a] = *(const u32x2*)(proj + (size_t)(r0 + t) * EVEN_IN + 32 * db + 8 * a + 4 * hh);
      bs = p.in[6][(size_t)j * 8 * 128 + t]; }
    for (int h = 0; h < 8; ++h) {
        __syncthreads();
        *(LAS u32x4*)(vl + (ls * AT_KP + ld0) * 2) = va; *(LAS u32x4*)(vl + (ls * AT_KP + ld0 + 8) * 2) = vb;
        __syncthreads();
        if (h < 7) { va = *(const u32x4*)(vsrc + (h + 1) * 64); vb = *(const u32x4*)(vsrc + (h + 1) * 64 + 8); }
        bf16x8 bcur[8]; u32x2 ucur[4]; const float bsc = bs;
#pragma unroll
        for (int ks = 0; ks < 8; ++ks) bcur[ks] = bfr[ks];
#pragma unroll
        for (int a = 0; a < 4; ++a) ucur[a] = uw[a];
        if (h < 7) { const bf16_t* W = F.wt(WE_SGU) + ((size_t)j * 8 + h + 1) * 128 * 128;
#pragma unroll
            for (int ks = 0; ks < 8; ++ks) if (ks < nks) bfr[ks] = *(const bf16x8*)(W + (size_t)t * 128 + ks * 16 + hh * 8);
#pragma unroll
            for (int a = 0; a < 4; ++a) uw[a] = *(const u32x2*)(proj + (size_t)(r0 + t) * EVEN_IN + (h + 1) * 64 + 32 * db + 8 * a + 4 * hh);
            bs = p.in[6][((size_t)j * 8 + h + 1) * 128 + t]; }
        f32x16 acc;
#pragma unroll
        for (int i = 0; i < 16; ++i) acc[i] = 0.f;
#pragma unroll
        for (int ks = 0; ks < 8; ++ks) if (ks < nks) {
            const s16x4 lo = tr_read(vl + ks * 16 * AT_KP * 2 + trb), hi = tr_read(vl + ks * 16 * AT_KP * 2 + trb + 4 * AT_KP * 2);
            acc = MFMA32(((bf16x8){lo[0], lo[1], lo[2], lo[3], hi[0], hi[1], hi[2], hi[3]}), bcur[ks], acc); }
#pragma unroll
        for (int a = 0; a < 4; ++a) {
            const int d0 = 32 * db + 8 * a + 4 * hh;
            u32x2 w; w.x = cvt_pk_bf16(bf_lo(ucur[a].x) * (acc[4 * a] + bsc), bf_hi(ucur[a].x) * (acc[4 * a + 1] + bsc)); w.y = cvt_pk_bf16(bf_lo(ucur[a].y) * (acc[4 * a + 2] + bsc), bf_hi(ucur[a].y) * (acc[4 * a + 3] + bsc));
            *(u32x2*)(y + (size_t)(r0 + t) * D + h * 64 + d0) = w; }
    }
}

template <int WIN>
__device__ __forceinline__ void pool_strip(const bf16_t* col, int r0, int pos0, int t0, LAS unsigned char* dst) {
    u32x4 rw[WIN + 3];
#pragma unroll
    for (int i = 0; i < WIN + 3; ++i) { const int r = t0 - (WIN - 1) + i; const int rr = pos0 + r >= 0 ? r : t0;
        rw[i] = *(const u32x4*)(col + (size_t)(r0 + rr) * ODD_N); }
    float sum[8];
#pragma unroll
    for (int q = 0; q < 8; ++q) sum[q] = 0.f;
#pragma unroll
    for (int i = 0; i < WIN - 1; ++i) { const float mk = pos0 + t0 - (WIN - 1) + i >= 0 ? 1.0f : 0.0f; const u32x4 w = rw[i];
        sum[0] += mk * bf_lo(w.x); sum[1] += mk * bf_hi(w.x); sum[2] += mk * bf_lo(w.y); sum[3] += mk * bf_hi(w.y); sum[4] += mk * bf_lo(w.z); sum[5] += mk * bf_hi(w.z); sum[6] += mk * bf_lo(w.w); sum[7] += mk * bf_hi(w.w); }
#pragma unroll
    for (int dt = 0; dt < 4; ++dt) {
        const int pos = pos0 + t0 + dt; const u32x4 w = rw[WIN - 1 + dt];
        const float xv[8] = {bf_lo(w.x), bf_hi(w.x), bf_lo(w.y), bf_hi(w.y), bf_lo(w.z), bf_hi(w.z), bf_lo(w.w), bf_hi(w.w)};
#pragma unroll
        for (int q = 0; q < 8; ++q) sum[q] += xv[q];
        const int cnt = pos + 1 < WIN ? pos + 1 : WIN; const float ic = 1.0f / (float)cnt;
        u32x4 o; o.x = cvt_pk_bf16(sum[0] * ic - xv[0], sum[1] * ic - xv[1]); o.y = cvt_pk_bf16(sum[2] * ic - xv[2], sum[3] * ic - xv[3]);
        o.z = cvt_pk_bf16(sum[4] * ic - xv[4], sum[5] * ic - xv[5]); o.w = cvt_pk_bf16(sum[6] * ic - xv[6], sum[7] * ic - xv[7]);
        *(LAS u32x4*)(dst + (t0 + dt) * SG_P * 2) = o;
        { const float mk = pos - (WIN - 1) >= 0 ? 1.0f : 0.0f; const u32x4 wo = rw[dt];
          sum[0] -= mk * bf_lo(wo.x); sum[1] -= mk * bf_hi(wo.x); sum[2] -= mk * bf_lo(wo.y); sum[3] -= mk * bf_hi(wo.y); sum[4] -= mk * bf_lo(wo.z); sum[5] -= mk * bf_hi(wo.z); sum[6] -= mk * bf_lo(wo.w); sum[7] -= mk * bf_hi(wo.w); } }
}

__device__ __forceinline__ void pool_unit(const Frame& F, int j, int unit) {
    CParams& p = *F.p;
    const bf16_t* proj = F.r1(); bf16_t* y = F.ybuf();
    const int r0 = unit * 128, pos0 = r0 & (SEQ - 1), lane = F.lane, r32 = lane & 31, hh = lane >> 5, tb = F.wid & 3, dbp = F.wid >> 2;
    LAS bf16_t* pl = (LAS bf16_t*)F.lds;
    for (int g = 0; g < 4; ++g) {
        const int win = 2 << g;
        __syncthreads();
        { const int t0 = (F.tid >> 4) * 4, c8 = (F.tid & 15) * 8;
          const bf16_t* col = proj + 1536 + g * 128 + c8;
          if (g == 0) pool_strip<2>(col, r0, pos0, t0, (LAS unsigned char*)pl + c8 * 2);
          else if (g == 1) pool_strip<4>(col, r0, pos0, t0, (LAS unsigned char*)pl + c8 * 2);
          else if (g == 2) pool_strip<8>(col, r0, pos0, t0, (LAS unsigned char*)pl + c8 * 2);
          else pool_strip<16>(col, r0, pos0, t0, (LAS unsigned char*)pl + c8 * 2); }
        __syncthreads();
        const bf16_t* W = F.wt(WO_POOL) + ((size_t)j * 4 + g) * 128 * 128;
#pragma unroll
        for (int dd = 0; dd < 2; ++dd) {
            const int db = dbp * 2 + dd;
            f32x16 acc;
#pragma unroll
            for (int i = 0; i < 16; ++i) acc[i] = 0.f;
#pragma unroll
            for (int ks = 0; ks < 8; ++ks) {
                const bf16x8 af = *(const bf16x8*)(W + (size_t)(32 * db + r32) * 128 + ks * 16 + hh * 8);
                const bf16x8 bf = *(const LAS bf16x8*)((LAS unsigned char*)pl + ((32 * tb + r32) * SG_P + ks * 16 + hh * 8) * 2);
                acc = MFMA32(af, bf, acc); }
            const int t = 32 * tb + r32;
#pragma unroll
            for (int a = 0; a < 4; ++a) {
                const int d0 = 32 * db + 8 * a + 4 * hh;
                const f32x4 sc = *(const f32x4*)(p.in[14] + (size_t)j * 512 + g * 128 + d0);
                u32x2 w; w.x = cvt_pk_bf16(acc[4 * a] * sc[0], acc[4 * a + 1] * sc[1]); w.y = cvt_pk_bf16(acc[4 * a + 2] * sc[2], acc[4 * a + 3] * sc[3]);
                *(u32x2*)(y + (size_t)(r0 + t) * D + 512 + g * 128 + d0) = w; }
        }
    }
}

__device__ __forceinline__ void router_phase(const Frame& F, int layer) {
    CParams& p = *F.p;
    constexpr int RWP = 1032;
    LAS bf16_t* wls = (LAS bf16_t*)F.lds;
    LAS float* lgs = (LAS float*)(F.lds + 86016) + F.wid * (16 * 33);
    LAS int* se = (LAS int*)(F.lds + 104448);
    const bf16_t* rwh = (const bf16_t*)(F.ws + WS_SM + SM_RWB) + (size_t)layer * 2 * 32 * D;
    __syncthreads();
    for (int i = F.tid; i < 2 * 20 * 128; i += NTHREADS) { const int hl = i / (20 * 128), o = (i / 128) % 20, c = i & 127;
        *(LAS u32x4*)((LAS unsigned char*)wls + ((hl * 20 + o) * RWP + c * 8) * 2) = *(const u32x4*)(rwh + (size_t)hl * 32 * D + (size_t)o * D + c * 8); }
    __syncthreads();
    const float* ssB = F.smf(SM_SSB);
    float* rstd1 = F.smf(SM_RSTD1); int* tokrec = F.smi(SM_TOKREC);
    const int l15 = F.lane & 15, lq = F.lane >> 4;
    for (int blk = F.bid; blk < T / 128; blk += F.G) {
        const int row0 = blk * 128 + F.wid * 16;
        const bf16_t* xp = F.hb() + (size_t)(row0 + l15) * D + 8 * lq;
        const LAS unsigned char* wh0 = (const LAS unsigned char*)wls + (l15 * RWP + 8 * lq) * 2; const LAS unsigned char* wl0 = wh0 + 20 * RWP * 2;
        const int o1 = l15 < 4 ? 16 + l15 : 0; const bool z1 = l15 >= 4;
        const LAS unsigned char* wh1 = (const LAS unsigned char*)wls + (o1 * RWP + 8 * lq) * 2; const LAS unsigned char* wl1 = wh1 + 20 * RWP * 2;
        f32x4 acc0 = (f32x4){0.f, 0.f, 0.f, 0.f}, acc1 = (f32x4){0.f, 0.f, 0.f, 0.f};
#pragma unroll 8
        for (int ks = 0; ks < 32; ++ks) {
            const bf16x8 ah = *(const bf16x8*)(xp + ks * 32);
            const bf16x8 bh0 = *(const LAS bf16x8*)(wh0 + ks * 64), bl0 = *(const LAS bf16x8*)(wl0 + ks * 64);
            bf16x8 bh1 = *(const LAS bf16x8*)(wh1 + ks * 64), bl1 = *(const LAS bf16x8*)(wl1 + ks * 64);
            if (z1) { bh1 = (bf16x8){0, 0, 0, 0, 0, 0, 0, 0}; bl1 = bh1; }
            acc0 = __builtin_amdgcn_mfma_f32_16x16x32_bf16(ah, bh0, acc0, 0, 0, 0); acc0 = __builtin_amdgcn_mfma_f32_16x16x32_bf16(ah, bl0, acc0, 0, 0, 0);
            acc1 = __builtin_amdgcn_mfma_f32_16x16x32_bf16(ah, bh1, acc1, 0, 0, 0); acc1 = __builtin_amdgcn_mfma_f32_16x16x32_bf16(ah, bl1, acc1, 0, 0, 0);
        }
#pragma unroll
        for (int e = 0; e < 4; ++e) { lgs[(4 * lq + e) * 33 + l15] = acc0[e]; lgs[(4 * lq + e) * 33 + 16 + l15] = acc1[e]; }
        __syncthreads();
        if (F.lane < 16) {
            const int row = row0 + F.lane;
            const float rs = rstd_from16(ssB + (size_t)row * 16);
            float lg[4], le[16];
#pragma unroll
            for (int o = 0; o < 4; ++o) lg[o] = lgs[F.lane * 33 + o] * rs + p.in[17][layer * 4 + o];
#pragma unroll
            for (int o = 0; o < 16; ++o) le[o] = lgs[F.lane * 33 + 4 + o] * rs + p.in[19][layer * 16 + o];
            int gi = 0; float gm = lg[0]; float v[4] = {le[0], le[1], le[2], le[3]};
#pragma unroll
            for (int o = 1; o < 4; ++o) { const bool better = lg[o] > gm; gm = better ? lg[o] : gm; gi = better ? o : gi;
                v[0] = better ? le[4 * o] : v[0]; v[1] = better ? le[4 * o + 1] : v[1]; v[2] = better ? le[4 * o + 2] : v[2]; v[3] = better ? le[4 * o + 3] : v[3]; }
            float den = 0.f;
#pragma unroll
            for (int o = 0; o < 4; ++o) den += expf(lg[o] - gm);
            const float gpv = 1.0f / den;
            int i0 = 0; float m0 = v[0];
#pragma unroll
            for (int o = 1; o < 4; ++o) if (v[o] > m0) { m0 = v[o]; i0 = o; }
            int i1 = -1; float m1 = -INFINITY;
#pragma unroll
            for (int o = 0; o < 4; ++o) if (o != i0 && v[o] > m1) { m1 = v[o]; i1 = o; }
            const float w0 = gpv / (1.0f + expf(m1 - m0)), w1 = gpv - w0;
            rstd1[row] = rs;
            int* tr = tokrec + (size_t)row * 4; tr[0] = gi * 4 + i0; tr[1] = gi * 4 + i1; tr[2] = __float_as_int(w0); tr[3] = __float_as_int(w1);
            se[(F.wid * 16 + F.lane) * 2] = gi * 4 + i0; se[(F.wid * 16 + F.lane) * 2 + 1] = gi * 4 + i1;
        }
        __syncthreads();
#pragma unroll
        for (int q = 0; q < 2; ++q) {
            const int e = F.wid * 2 + q; int n = 0; int* lst = F.smi(SM_LISTS) + ((size_t)blk * 16 + e) * 128;
#pragma unroll
            for (int r = 0; r < 2; ++r) {
                const int t = r * 64 + F.lane; const bool a0 = se[2 * t] == e, a1 = se[2 * t + 1] == e; const bool m = a0 || a1;
                const unsigned long long mask = __builtin_amdgcn_ballot_w64(m);
                const int pos = n + (int)__builtin_amdgcn_mbcnt_hi((unsigned)(mask >> 32), __builtin_amdgcn_mbcnt_lo((unsigned)mask, 0u));
                if (m) lst[pos] = (blk * 128 + t) * 2 + (a1 ? 1 : 0);
                n += __builtin_popcountll(mask); }
            if (F.lane == 0) F.smi(SM_COUNTS)[blk * 16 + e] = n; }
        __syncthreads();
    }
    { const float* ps = p.in[1] + (size_t)layer * T * PLE; bf16_t* pb = F.ybuf();
      for (size_t i = (size_t)F.bid * NTHREADS + F.tid; i < (size_t)T * PLE / 8; i += (size_t)F.G * NTHREADS) {
          const f32x4 a = *(const f32x4*)(ps + i * 8), b = *(const f32x4*)(ps + i * 8 + 4);
          u32x4 w; w.x = cvt_pk_bf16(a[0], a[1]); w.y = cvt_pk_bf16(a[2], a[3]); w.z = cvt_pk_bf16(b[0], b[1]); w.w = cvt_pk_bf16(b[2], b[3]);
          *(u32x4*)(pb + i * 8) = w; } }
}

__device__ __forceinline__ void scatter_phase(const Frame& F) {
    LAS int* cn = (LAS int*)F.lds;
    LAS int* part = (LAS int*)(F.lds + 16384);
    LAS int* tot = (LAS int*)(F.lds + 16384 + 2048);
    LAS int* pre = tot + 16; LAS int* base = tot + 32;
    const int* counts = F.smi(SM_COUNTS);
    __syncthreads();
    for (int i = F.tid; i < 4096; i += NTHREADS) cn[i] = counts[i];
    __syncthreads();
    { const int e = F.tid & 15, ch = F.tid >> 4; int s = 0;
#pragma unroll
      for (int q = 0; q < 8; ++q) s += cn[(ch * 8 + q) * 16 + e];
      part[ch * 16 + e] = s; }
    __syncthreads();
    for (int blk = F.bid; blk < 256; blk += F.G) {
        __syncthreads();
        if (F.tid < 16) { int tt = 0, pp = 0; const int bch = blk >> 3;
            for (int ch = 0; ch < 32; ++ch) { const int v = part[ch * 16 + F.tid]; tt += v; pp += ch < bch ? v : 0; }
            for (int q = bch * 8; q < blk; ++q) pp += cn[q * 16 + F.tid];
            tot[F.tid] = tt; pre[F.tid] = pp; }
        __syncthreads();
        if (F.tid == 0) { int bsum = 0; for (int e = 0; e < 16; ++e) { base[e] = bsum; bsum += (tot[e] + 255) & ~255; } base[16] = bsum;
            if (blk == 0) { int* eb = F.smi(SM_EBASE); for (int e = 0; e <= 16; ++e) eb[e] = base[e]; } }
        __syncthreads();
        int* rowtok = F.smi(SM_ROWTOK); float* roww = F.smf(SM_ROWW); float* rowrs = F.smf(SM_ROWRS);
        const int* tokrec = F.smi(SM_TOKREC); const float* rstd1 = F.smf(SM_RSTD1);
        if (F.tid < 256) {
            int e = 0, idx = F.tid;
            for (int q = 0; q < 16; ++q) { const int c = cn[blk * 16 + q]; if (e == q && idx >= c) { idx -= c; e = q + 1; } }
            if (e < 16) {
                const int item = F.smi(SM_LISTS)[((size_t)blk * 16 + e) * 128 + idx];
                const int pos = base[e] + pre[e] + idx, tok = item >> 1;
                rowtok[pos] = item; roww[pos] = __int_as_float(tokrec[(size_t)tok * 4 + 2 + (item & 1)]); rowrs[pos] = rstd1[tok]; } }
        if (blk < 16) { const int e = blk; for (int q = base[e] + tot[e] + F.tid; q < base[e + 1]; q += NTHREADS) rowtok[q] = -1; }
    }
    __syncthreads();
}

__device__ __forceinline__ void combine_phase(const Frame& F) {
    bf16_t* hb = F.hb(); const bf16_t* Y = F.r1(); float* rstd2 = F.smf(SM_RSTD2);
    for (int row = F.bid * 8 + F.wid; row < T; row += F.G * 8) {
        float q = 0.f;
#pragma unroll
        for (int hf = 0; hf < 2; ++hf) { const size_t off = (size_t)row * D + hf * 512 + F.lane * 8;
            const u32x4 hw = *(const u32x4*)(hb + off), y0 = *(const u32x4*)(Y + off), y1 = *(const u32x4*)(Y + (size_t)T * D + off);
            f32x4 a, b;
            a[0] = bf_lo(hw.x) + (bf_lo(y0.x) + bf_lo(y1.x)); a[1] = bf_hi(hw.x) + (bf_hi(y0.x) + bf_hi(y1.x)); a[2] = bf_lo(hw.y) + (bf_lo(y0.y) + bf_lo(y1.y)); a[3] = bf_hi(hw.y) + (bf_hi(y0.y) + bf_hi(y1.y));
            b[0] = bf_lo(hw.z) + (bf_lo(y0.z) + bf_lo(y1.z)); b[1] = bf_hi(hw.z) + (bf_hi(y0.z) + bf_hi(y1.z)); b[2] = bf_lo(hw.w) + (bf_lo(y0.w) + bf_lo(y1.w)); b[3] = bf_hi(hw.w) + (bf_hi(y0.w) + bf_hi(y1.w));
            u32x4 w; w.x = cvt_pk_bf16(a[0], a[1]); w.y = cvt_pk_bf16(a[2], a[3]); w.z = cvt_pk_bf16(b[0], b[1]); w.w = cvt_pk_bf16(b[2], b[3]);
            *(u32x4*)(hb + off) = w;
            q += (a[0] * a[0] + a[1] * a[1]) + (a[2] * a[2] + a[3] * a[3]) + (b[0] * b[0] + b[1] * b[1]) + (b[2] * b[2] + b[3] * b[3]); }
        q = wave_sum(q);
        if (F.lane == 0) { rstd2[row] = 1.0f / sqrtf(q * (1.0f / 1024.0f) + EPS); F.smf(SM_RSTDE)[row] = rstd_from16(F.smf(SM_SSE) + (size_t)row * 16); }
    }
}

constexpr int FOX_KB = 86016, FOX_SCAN = FOX_KB + 32768;
static_assert(attn_body::ATTN_LDS_BYTES <= FOX_KB && FOX_SCAN + 128 <= RING_BYTES, "attention LDS map");
__device__ __forceinline__ void fox_kbias(const Frame& F, int b, int h, const float* logf, const float* gqn, const float* gkn) {
    LAS u32x2* krec = (LAS u32x2*)(F.lds + FOX_KB); LAS float* wsum = (LAS float*)(F.lds + FOX_SCAN);
    __syncthreads();
    float v[8]; float run = 0.f;
    { const float* lp = logf + ((size_t)b * 8 + h) * SEQ + F.tid * 8; const f32x4 l0 = *(const f32x4*)lp, l1 = *(const f32x4*)(lp + 4);
      const float lv[8] = {l0[0], l0[1], l0[2], l0[3], l1[0], l1[1], l1[2], l1[3]};
#pragma unroll
      for (int j = 0; j < 8; ++j) { run += lv[j]; v[j] = run; } }
    float inc = run;
#pragma unroll
    for (int o = 1; o < 64; o <<= 1) { const float t = __int_as_float(__builtin_amdgcn_ds_bpermute((F.lane - o) << 2, __float_as_int(inc))); if (F.lane >= o) inc += t; }
    if (F.lane == 63) wsum[F.wid] = inc;
    __syncthreads();
    float base = inc - run;
    for (int w = 0; w < F.wid; ++w) base += wsum[w];
#pragma unroll
    for (int j = 0; j < 8; ++j) { const float kb = -LOG2E * (base + v[j]);
        const unsigned ph = cvt_pk_bf16(kb, 0.f) & 0xffffu; const float r1 = kb - bf_lo(ph); const unsigned pm = cvt_pk_bf16(r1, 0.f) & 0xffffu; const float r2 = r1 - bf_lo(pm); const unsigned pl = cvt_pk_bf16(r2, 0.f) & 0xffffu;
        u32x2 rc; rc.x = ph | (pm << 16); rc.y = pl; krec[F.tid * 8 + j] = rc; }
    if (F.wid == 0) {
        float gq = fabsf(gqn[F.lane]), gk = fabsf(gkn[F.lane]);
#pragma unroll
        for (int o = 1; o < 64; o <<= 1) { gq = fmaxf(gq, __int_as_float(__builtin_amdgcn_ds_bpermute((F.lane ^ o) << 2, __float_as_int(gq)))); gk = fmaxf(gk, __int_as_float(__builtin_amdgcn_ds_bpermute((F.lane ^ o) << 2, __float_as_int(gk)))); }
        if (F.lane == 0) wsum[8] = 150.0f + 2.0f * 1.03f * (QSCALE * 64.0f * gq * gk); }
    __syncthreads();
}
__device__ __forceinline__ int fox_tstart(const Frame& F, int qb) {
    const LAS u32x2* krec = (const LAS u32x2*)(F.lds + FOX_KB); const float thr = ((const LAS float*)(F.lds + FOX_SCAN))[8];
    const u32x2 rq = krec[qb * 256]; const float kq = (bf_lo(rq.x) + bf_hi(rq.x)) + bf_lo(rq.y); int t = 0;
    while (t < 4 * qb) { const u32x2 rk = krec[64 * t + 63]; if (!(kq - ((bf_lo(rk.x) + bf_hi(rk.x)) + bf_lo(rk.y)) > thr)) break; ++t; }
    return t & ~1;
}

constexpr int PH_PER_LAYER = 9;
__device__ __forceinline__ void run_phase(const Frame& F, int ph, int layer) {
    CParams& p = *F.p; const int j = layer >> 1; const bool odd = layer & 1;
    if (ph == 0) { p0_prologue(F); return; }
    if (ph == 1) {
        if (odd) { const Frame F1 = F.fresh(); logf_units(F1, j); }
        pg8::SchedStd S; S.A = (const char*)F.x0(); S.lda = D; S.K = D; S.nM = T / 256; S.G = F.G; S.c = F.bid;
        pg8::EpiInProj E; E.out = F.r1(); E.rtab = (const LAS float*)(F.lds + RSTD_TAB); E.odd = odd ? 1 : 0;
        if (odd) { S.B = (const char*)F.wt(WO_IN + (size_t)j * ODD_N * D); S.nN = ODD_N / 256; E.ldo = ODD_N; E.g0 = p.in[11] + j * 64; E.g1 = p.in[12] + j * 64; }
        else { S.B = (const char*)F.wt(WE_IN + (size_t)j * EVEN_IN * D); S.nN = EVEN_IN / 256; E.ldo = EVEN_IN; E.g0 = p.in[7] + (size_t)j * 8 * 64; E.g1 = nullptr; }
        { const Frame F1 = F.fresh(); LAS float* tab = (LAS float*)(F1.lds + RSTD_TAB); const float* ssA = F1.smf(SM_SSA);
          for (int idx = F1.tid; idx < 5 * 256; idx += NTHREADS) { pg8::Unit u; if (S.next(idx >> 8, u)) tab[idx] = rstd_from16(ssA + (size_t)(u.pm * 256 + (idx & 255)) * 16); }
          __syncthreads(); }
        pg8::gemm_phase(F.lds, S, E, D, F.tid);
        return; }
    if (ph == 2) {
        if (!odd) {
#pragma unroll 1
            for (int rp = 0; rp < 1 + (PROBE2 & 1); ++rp) { const Frame F1 = F.fresh(); for (int u = F1.bid; u < 256; u += F1.G) sgu_unit(F1, j, u); }
#pragma unroll 1
            for (int rp = 0; rp < 1 + ((PROBE2 >> 1) & 1); ++rp) {
            const Frame F2 = F.fresh();
            const bf16_t* pr = F2.r1();
            __syncthreads();
            {
                unsigned* ctr = (unsigned*)(F2.ws + WS_CTL) + CW_QUEUE + ((layer * 2 + rp) * 8 + (F2.bid & 7)) * 64;
                for (;;) {
                    unsigned kk = 0; if (F2.lane == 0) kk = __hip_atomic_fetch_add(ctr, 1u, __ATOMIC_RELAXED, __HIP_MEMORY_SCOPE_AGENT);
                    const int k = __builtin_amdgcn_readfirstlane((int)kk);
                    if (k >= 1024) break;
                    const int u = (F2.bid & 7) + 8 * k;
                    sb_wave_unit(F2, pr + 1024, pr + 1536, pr + 2048, EVEN_IN, F2.ybuf() + 512, D, u >> 10, (u >> 7) & 7, u & 127); } }
            __syncthreads(); }
        } else {
            const attn_body::bf16* pr = (const attn_body::bf16*)F.r1();
#pragma unroll 1
            for (int rp = 0; rp < 1 + ((PROBE2 >> 2) & 1); ++rp)
            for (int c = F.bid; c < 256; c += F.G) {
                const int bb = c >> 5, aa = (c >> 3) & 3, h0 = c & 7;
#pragma unroll 1
                for (int i = 0; i < 4; ++i) { const int qb = i == 0 ? aa : i == 1 ? 7 - aa : i == 2 ? 8 + aa : 15 - aa; const int hd = (h0 + 2 * i) & 7;
                    { const Frame F1 = F.fresh(); fox_kbias(F1, bb, hd, F1.smf(SM_LOGF), p.in[11] + j * 64, p.in[12] + j * 64); }
                    const Frame F2 = F.fresh();
                    attn_body::attn_unit<64>(bb, hd, qb, pr, pr + 512, pr + 1024, (attn_body::bf16*)F2.ybuf(), (char*)F2.lds, (const char*)F2.lds + FOX_KB, F2.tid, fox_tstart(F2, qb)); }
            }
#pragma unroll 1
            for (int rp = 0; rp < 1 + ((PROBE2 >> 3) & 1); ++rp) { const Frame F3 = F.fresh(); for (int u = F3.bid; u < 256; u += F3.G) pool_unit(F3, j, u); }
        }
        return; }
    if (ph == 3) {
        pg8::SchedStd S; S.A = (const char*)F.ybuf(); S.lda = D; S.K = D; S.nM = T / 256; S.nN = 4; S.G = F.G; S.c = F.bid;
        S.B = (const char*)(odd ? F.wt(WO_OUT + (size_t)j * D * D) : F.wt(WE_OUT + (size_t)j * D * D));
        pg8::EpiResid E; E.hin = F.x0(); E.hb = F.hb(); E.ss = F.smf(SM_SSB);
        pg8::gemm_phase(F.lds, S, E, D, F.tid);
        return; }
    if (ph == 4) { router_phase(F, layer); return; }
    if (ph == 5) { scatter_phase(F); return; }
    if (ph == 6) {
        int n_up;
        { pg8::SchedUp S; S.init(F.smi(SM_EBASE), F.G, F.bid, 2); S.A = (const char*)F.hb(); S.B = (const char*)F.wt(WL_UP + (size_t)layer * NEXP * 512 * D); S.rowtok = F.smi(SM_ROWTOK); S.K = D;
          n_up = S.total_rt * 2;
          pg8::EpiUp E; E.act = F.r2(); E.rowtok = F.smi(SM_ROWTOK); E.roww = F.smf(SM_ROWW); E.rowrs = F.smf(SM_ROWRS);
          pg8::gemm_phase(F.lds, S, E, D, F.tid); }
        { const Frame F1 = F.fresh();
          const int rem = n_up % F1.G, nlight = rem ? F1.G - rem : F1.G, v = rem ? (F1.bid - rem) : F1.bid;
          pg8::SchedStd S; S.A = (const char*)F1.ybuf(); S.lda = PLE; S.K = PLE; S.nM = T / 256; S.nN = 4; S.G = nlight; S.c = v >= 0 ? v : 0x40000000;
          S.B = (const char*)F1.wt(WL_PP + (size_t)layer * D * PLE);
          pg8::EpiEproj E; E.eraw = F1.r3(); E.ss = F1.smf(SM_SSE);
          pg8::gemm_phase(F1.lds, S, E, PLE, F1.tid); }
        return; }
    if (ph == 7) {
        pg8::SchedDown S; S.init(F.smi(SM_EBASE), F.G, F.bid, 4); S.A = (const char*)F.r2(); S.B = (const char*)F.wt(WL_DN + (size_t)layer * NEXP * D * DEXP); S.K = DEXP;
        pg8::EpiDown E; E.Y = F.r1(); E.rowtok = F.smi(SM_ROWTOK);
        pg8::gemm_phase(F.lds, S, E, DEXP, F.tid);
        return; }
    if (ph == 8) { combine_phase(F); return; }
    if (ph == 9) {
        pg8::SchedStd S; S.A = (const char*)F.hb(); S.lda = D; S.K = D; S.nM = T / 256; S.nN = 4; S.G = F.G; S.c = F.bid;
        S.B = (const char*)F.wt(WL_PG + (size_t)layer * D * D);
        pg8::EpiPle E; E.h = F.hb(); E.xn = F.x0(); E.fout = layer == 3 ? p.out : nullptr; E.ss = F.smf(SM_SSA); E.rstd2 = F.smf(SM_RSTD2); E.rstdE = F.smf(SM_RSTDE); E.eraw = F.r3(); E.gE = p.in[24] + layer * D;
        pg8::gemm_phase(F.lds, S, E, D, F.tid);
        return; }
}

template <int PH> __global__ void __launch_bounds__(NTHREADS, 2) k_phase(Params p, int layer) {
    extern __shared__ __attribute__((aligned(16))) unsigned char lds_raw[];
    Frame F; F.p = (CParams*)__builtin_amdgcn_kernarg_segment_ptr(); F.ws = p.ws; F.lds = (LAS unsigned char*)lds_raw; F.tid = threadIdx.x; F.lane = F.tid & 63; F.wid = __builtin_amdgcn_readfirstlane(F.tid >> 6); F.G = gridDim.x; F.bid = blockIdx.x;
    run_phase(F, PH, layer);
}

template <int PH> static void launch_phase(const Params& p, int layer, int grid, hipStream_t stream) {
    static bool attr = false;
    if (!attr) { (void)hipFuncSetAttribute((const void*)k_phase<PH>, hipFuncAttributeMaxDynamicSharedMemorySize, LDS_BYTES); attr = true; }
    hipLaunchKernelGGL((k_phase<PH>), dim3(grid), dim3(NTHREADS), LDS_BYTES, stream, p, layer);
}

constexpr int CW_BAR = 1024;
#define MEGA_PHASE(ph) do { int tb_ = 1; _Pragma("unroll 1") for (int rep_ = 0; rep_ < 1 + ((PROBE_MASK >> (ph)) & 1); ++rep_) { \
        CParams* q_ = pp; int t_, w_ = wid0, g_ = (int)gridDim.x, b_ = (int)blockIdx.x; asm volatile("v_mbcnt_lo_u32_b32 %1, -1, 0\n\tv_mbcnt_hi_u32_b32 %1, -1, %1\n\tv_lshl_add_u32 %1, %4, 6, %1" : "+s"(q_), "=&v"(t_), "+s"(g_), "+s"(b_) : "s"(w_)); \
        Frame F; F.p = q_; F.ws = q_->ws; F.lds = (LAS unsigned char*)lds_raw; F.tid = t_; F.lane = t_ & 63; F.wid = __builtin_amdgcn_readfirstlane(t_ >> 6); F.G = g_; F.bid = b_; \
        run_phase(F, ph, layer); } \
        asm volatile("v_mbcnt_lo_u32_b32 %0, -1, 0\n\tv_mbcnt_hi_u32_b32 %0, -1, %0\n\tv_lshl_add_u32 %0, %1, 6, %0" : "=&v"(tb_) : "s"(wid0)); \
        { XcdBarrier b_; b_.bar = (unsigned*)(pp->ws + WS_CTL) + CW_BAR; b_.x = barx; b_.st = st; asm volatile("" : "+s"(b_.x)); xcd_barrier(b_, tb_ == 0); if (PROBE_BAR) xcd_barrier(b_, tb_ == 0); } } while (0)
__global__ void __launch_bounds__(NTHREADS, 2) k_mega(Params p) {
    extern __shared__ __attribute__((aligned(16))) unsigned char lds_raw[];
    CParams* pp = (CParams*)__builtin_amdgcn_kernarg_segment_ptr();
    volatile LAS unsigned* st = (volatile LAS unsigned*)((LAS unsigned char*)lds_raw + MISC_OFF);
    const int wid0 = __builtin_amdgcn_readfirstlane((int)threadIdx.x >> 6);
    if (threadIdx.x < 4) st[threadIdx.x] = 0u;
    __syncthreads();
    const unsigned barx = xcd_barrier_post((unsigned*)(pp->ws + WS_CTL) + CW_BAR, st).x;
    { const int layer = 0; MEGA_PHASE(0); }
#pragma unroll 1
    for (int layer = 0; layer < 4; ++layer) {
        MEGA_PHASE(1); MEGA_PHASE(2); MEGA_PHASE(3); MEGA_PHASE(4); MEGA_PHASE(5); MEGA_PHASE(6); MEGA_PHASE(7); MEGA_PHASE(8); MEGA_PHASE(9);
    }
}

extern "C" void kernel_launch(void* const* d_in, const int* in_sizes, int n_in, void* d_out, int out_size, void* d_ws, size_t ws_size, hipStream_t stream) {
    if (n_in != 26 || out_size != T * D || ws_size < WS_END) { fprintf(stderr, "kernel_launch: unexpected shapes (n_in %d, out %d, ws %zu, need %zu)\n", n_in, out_size, ws_size, (size_t)WS_END); return; }
    Params p{};
    for (int i = 0; i < 26; ++i) p.in[i] = (const float*)d_in[i];
    p.out = (float*)d_out; p.ws = (unsigned char*)d_ws;
    (void)hipMemsetAsync((char*)d_ws + WS_CTL, 0, 131072, stream);
#if MEGA
    static int grid = 0;
    if (!grid) {
        int dev = 0, cus = 0, per_cu = 0;
        (void)hipGetDevice(&dev); (void)hipDeviceGetAttribute(&cus, hipDeviceAttributeMultiprocessorCount, dev);
        (void)hipFuncSetAttribute((const void*)k_mega, hipFuncAttributeMaxDynamicSharedMemorySize, LDS_BYTES);
        (void)hipOccupancyMaxActiveBlocksPerMultiprocessor(&per_cu, k_mega, NTHREADS, LDS_BYTES);
        if (per_cu < 1) { fprintf(stderr, "kernel_launch: occupancy query says %d blocks per CU\n", per_cu); per_cu = 1; }
        grid = cus > 0 ? cus : 256;
    }
    hipLaunchKernelGGL(k_mega, dim3(grid), dim3(NTHREADS), LDS_BYTES, stream, p);
#else
    const int grid = 256;
    launch_phase<0>(p, 0, grid, stream);
    for (int layer = 0; layer < 4; ++layer) {
        launch_phase<1>(p, layer, grid, stream); launch_phase<2>(p, layer, grid, stream); launch_phase<3>(p, layer, grid, stream);
        launch_phase<4>(p, layer, grid, stream); launch_phase<5>(p, layer, grid, stream); launch_phase<6>(p, layer, grid, stream);
        launch_phase<7>(p, layer, grid, stream); launch_phase<8>(p, layer, grid, stream); launch_phase<9>(p, layer, grid, stream);
    }
#endif
}
```
